# Optimizing an MI355X kernel written in HIP

```python
import jax, jax.numpy as jnp
from jax import lax
import numpy as np

D_MODEL = 2048
BATCH = 4
SEQ = 4096
DEPTH = 1

HEAD_DIM = 128
HEADS_PER_GROUP = 4
DILATED_GROUPS = ((128, 1), (512, 4), (2048, 16))
N_ATT_GROUPS = 3
N_ATT_HEADS = N_ATT_GROUPS * HEADS_PER_GROUP
ATT_WIDTH = N_ATT_HEADS * HEAD_DIM
ATT_OUT_WIDTH = HEADS_PER_GROUP * HEAD_DIM
ROPE_DIM = HEAD_DIM // 4
ROPE_THETA = 500000.0
ATT_BLOCK = 128

SG_CHUNK = 128
SG_GROUPS = 12
SG_GROUP_DIM = 128
SG_WIDTH = SG_GROUPS * SG_GROUP_DIM

D_FF = 5632

NORM_EPS = 1e-6
LN_EPS = 1e-5
IN_WIDTH = 3 * ATT_WIDTH + 2 * SG_WIDTH + 2 * D_MODEL

kernel_name = "dilated_attn_gmlp_gated_macaron_layer"


def rmsnorm(x, g):
    x32 = x.astype(jnp.float32)
    r = x32 * lax.rsqrt(jnp.mean(x32 * x32, axis=-1, keepdims=True) + NORM_EPS)
    return (r * g.astype(jnp.float32)).astype(x.dtype)


def layernorm(x, g, b):
    x32 = x.astype(jnp.float32)
    mu = jnp.mean(x32, axis=-1, keepdims=True)
    var = jnp.mean(jnp.square(x32 - mu), axis=-1, keepdims=True)
    y = (x32 - mu) * lax.rsqrt(var + LN_EPS)
    return (y * g.astype(jnp.float32) + b.astype(jnp.float32)).astype(x.dtype)


def swiglu(x, w_gate, w_up, w_down):
    return (jax.nn.silu(x @ w_gate) * (x @ w_up)) @ w_down


def partial_rope(t, pos):
    half = ROPE_DIM // 2
    inv_freq = ROPE_THETA ** (-jnp.arange(0, ROPE_DIM, 2, dtype=jnp.float32) / ROPE_DIM)
    ang = pos.astype(jnp.float32)[:, None] * inv_freq[None, :]
    ang = ang.reshape((1, t.shape[1]) + (1,) * (t.ndim - 3) + (half,))
    cos = jnp.cos(ang).astype(t.dtype)
    sin = jnp.sin(ang).astype(t.dtype)
    x1 = t[..., :half]
    x2 = t[..., half:ROPE_DIM]
    return jnp.concatenate([x1 * cos - x2 * sin, x2 * cos + x1 * sin, t[..., ROPE_DIM:]], axis=-1)


def dilated_window_attention(q, k, v, window, dilation):
    b, s, h, hd = q.shape
    L = s // dilation
    n_blk = -(-L // ATT_BLOCK)
    Lp = n_blk * ATT_BLOCK
    reach = window // dilation

    def by_residue(t):
        t = t.reshape(b, L, dilation, h, hd).transpose(0, 3, 2, 1, 4)
        t = jnp.pad(t, ((0, 0), (0, 0), (0, 0), (0, Lp - L), (0, 0)))
        return t.reshape(b, h, dilation, n_blk, ATT_BLOCK, hd)

    qb, kb, vb = by_residue(q), by_residue(k), by_residue(v)

    def with_prev(t):
        prev = jnp.pad(t[:, :, :, :-1], ((0, 0), (0, 0), (0, 0), (1, 0), (0, 0), (0, 0)))
        return jnp.concatenate([prev, t], axis=4)

    kw, vw = with_prev(kb), with_prev(vb)
    scores = jnp.einsum('bhrnqd,bhrnkd->bhrnqk', qb, kw).astype(jnp.float32) * (hd ** -0.5)
    qi = jnp.arange(ATT_BLOCK)[None, :, None]
    kj = jnp.arange(2 * ATT_BLOCK)[None, None, :]
    blk = jnp.arange(n_blk)[:, None, None]
    diff = qi + ATT_BLOCK - kj
    key_idx = blk * ATT_BLOCK - ATT_BLOCK + kj
    valid = (diff >= 0) & (diff <= reach) & (key_idx >= 0)
    scores = jnp.where(valid[None, None, None], scores, -jnp.inf)
    m = jnp.max(scores, axis=-1, keepdims=True)
    p = jnp.exp(scores - m)
    l = jnp.sum(p, axis=-1, keepdims=True)
    o = jnp.einsum('bhrnqk,bhrnkd->bhrnqd', p.astype(vw.dtype), vw).astype(jnp.float32) / l

    o = o.reshape(b, h, dilation, Lp, hd)[:, :, :, :L].transpose(0, 3, 2, 1, 4).reshape(b, s, h, hd)

    def stat_back(t):
        t = t.reshape(b, h, dilation, Lp)[:, :, :, :L]
        return t.transpose(0, 3, 2, 1).reshape(b, s, h)

    return o, stat_back(m), stat_back(l)


def hybrid_mixer(h, w_in, sg_ln_g, sg_ln_b, sg_w, sg_b, w_att_out, w_sg_out, w_out):
    b, s, _ = h.shape
    proj = h @ w_in
    splits = np.cumsum([ATT_WIDTH, ATT_WIDTH, ATT_WIDTH, SG_WIDTH, SG_WIDTH, D_MODEL]).tolist()
    q, k, v, u, vs, g_att, g_sg = jnp.split(proj, splits, axis=-1)

    pos = jnp.arange(s)
    q = partial_rope(q.reshape(b, s, N_ATT_GROUPS, HEADS_PER_GROUP, HEAD_DIM), pos)
    k = partial_rope(k.reshape(b, s, N_ATT_GROUPS, HEADS_PER_GROUP, HEAD_DIM), pos)
    v = v.reshape(b, s, N_ATT_GROUPS, HEADS_PER_GROUP, HEAD_DIM)
    outs, maxes, dens = [], [], []
    for gi, (window, dilation) in enumerate(DILATED_GROUPS):
        o_g, m_g, l_g = dilated_window_attention(q[:, :, gi], k[:, :, gi], v[:, :, gi], window, dilation)
        outs.append(o_g)
        maxes.append(m_g)
        dens.append(l_g)
    o_all = jnp.stack(outs)
    m_all = jnp.stack(maxes)
    l_all = jnp.stack(dens)
    w_den = l_all * jnp.exp(m_all - jnp.max(m_all, axis=0, keepdims=True))
    o_att = jnp.sum(w_den[..., None] * o_all, axis=0) / jnp.sum(w_den, axis=0)[..., None]
    y_att = o_att.astype(h.dtype).reshape(b, s, ATT_OUT_WIDTH) @ w_att_out

    u = jax.nn.gelu(u, approximate=False)
    vs = layernorm(jax.nn.gelu(vs, approximate=False), sg_ln_g, sg_ln_b)
    vc = vs.reshape(b, s // SG_CHUNK, SG_CHUNK, SG_GROUPS, SG_GROUP_DIM)
    causal = jnp.tril(jnp.ones((SG_CHUNK, SG_CHUNK), dtype=sg_w.dtype))
    w_sp = sg_w * causal[None]
    spatial = jnp.einsum('gts,bcsgd->bctgd', w_sp, vc) + sg_b.T[None, None, :, :, None]
    y_sg = (u * spatial.reshape(b, s, SG_WIDTH)) @ w_sg_out

    merged = jax.nn.sigmoid(g_att) * y_att + jax.nn.sigmoid(g_sg) * y_sg
    return merged @ w_out


def setup_inputs(seed: int = 0) -> dict:
    key = jax.random.key(seed)
    ks = jax.random.split(key, 24)
    f32 = jnp.float32

    def nrm(k, shape, fan_in):
        return jax.random.normal(k, shape, f32) * (fan_in ** -0.5)

    def gain(k, shape):
        return 1.0 + 0.05 * jax.random.normal(k, shape, f32)

    return {
        "x": jax.random.normal(ks[0], (BATCH, SEQ, D_MODEL), f32),
        "ffn1_norm": gain(ks[1], (DEPTH, D_MODEL)),
        "ffn1_w_gate": nrm(ks[2], (DEPTH, D_MODEL, D_FF), D_MODEL),
        "ffn1_w_up": nrm(ks[3], (DEPTH, D_MODEL, D_FF), D_MODEL),
        "ffn1_w_down": nrm(ks[4], (DEPTH, D_FF, D_MODEL), D_FF),
        "mix_norm": gain(ks[5], (DEPTH, D_MODEL)),
        "w_in": nrm(ks[6], (DEPTH, D_MODEL, IN_WIDTH), D_MODEL),
        "sg_ln_g": gain(ks[7], (DEPTH, SG_WIDTH)),
        "sg_ln_b": 0.02 * jax.random.normal(ks[8], (DEPTH, SG_WIDTH), f32),
        "sg_w": nrm(ks[9], (DEPTH, SG_GROUPS, SG_CHUNK, SG_CHUNK), SG_CHUNK),
        "sg_b": gain(ks[10], (DEPTH, SG_GROUPS, SG_CHUNK)),
        "w_att_out": nrm(ks[11], (DEPTH, ATT_OUT_WIDTH, D_MODEL), ATT_OUT_WIDTH),
        "w_sg_out": nrm(ks[12], (DEPTH, SG_WIDTH, D_MODEL), SG_WIDTH),
        "w_out": nrm(ks[13], (DEPTH, D_MODEL, D_MODEL), D_MODEL),
        "ffn2_norm": gain(ks[14], (DEPTH, D_MODEL)),
        "ffn2_w_gate": nrm(ks[15], (DEPTH, D_MODEL, D_FF), D_MODEL),
        "ffn2_w_up": nrm(ks[16], (DEPTH, D_MODEL, D_FF), D_MODEL),
        "ffn2_w_down": nrm(ks[17], (DEPTH, D_FF, D_MODEL), D_FF),
        "final_norm": gain(ks[18], (D_MODEL,)),
    }


def reference(x, ffn1_norm, ffn1_w_gate, ffn1_w_up, ffn1_w_down, mix_norm, w_in, sg_ln_g, sg_ln_b,
              sg_w, sg_b, w_att_out, w_sg_out, w_out, ffn2_norm, ffn2_w_gate, ffn2_w_up, ffn2_w_down,
              final_norm):
    for i in range(DEPTH):
        x = x + 0.5 * swiglu(rmsnorm(x, ffn1_norm[i]), ffn1_w_gate[i], ffn1_w_up[i], ffn1_w_down[i])
        x = x + hybrid_mixer(rmsnorm(x, mix_norm[i]), w_in[i], sg_ln_g[i], sg_ln_b[i], sg_w[i], sg_b[i],
                             w_att_out[i], w_sg_out[i], w_out[i])
        x = x + 0.5 * swiglu(rmsnorm(x, ffn2_norm[i]), ffn2_w_gate[i], ffn2_w_up[i], ffn2_w_down[i])
    return rmsnorm(x, final_norm)
```

```cpp
#include <hip/hip_runtime.h>
#include <hip/hip_cooperative_groups.h>
#include <cstdio>
#include <cstdint>
#include <cmath>
namespace cg = cooperative_groups;
namespace pg8 {
#define PG8_LAS __attribute__((address_space(3)))
typedef unsigned short bf16_t;
typedef short bf16x8 __attribute__((ext_vector_type(8)));
typedef float f32x4 __attribute__((ext_vector_type(4)));
typedef unsigned u32x4 __attribute__((ext_vector_type(4)));
constexpr int BM = 256, BK = 64, HALF = 128, HTB = HALF * BK * 2  , STAGE_BYTES = 8 * HTB, NXCD = 8, WGM = 8;

__host__ __device__ __forceinline__ int lds_byte(int r, int c) { const int st = (r >> 4) * 2 + (c >> 5), rr = r & 15, cc = c & 31, ob = rr * 64 + cc * 2; return st * 1024 + (ob ^ (((ob >> 9) & 1) << 5)); }
__host__ __device__ __forceinline__ void stage_rc(int b, int& R, int& C) { const int st = b / 1024, sb = b % 1024, swz = sb ^ (((sb >> 9) & 1) << 5); R = (st >> 1) * 16 + swz / 64; C = (st & 1) * 32 + (swz % 64) / 2; }
__host__ __device__ __forceinline__ int perm32(int rho) { const int n = rho >> 4, i = rho & 15; return 8 * (i >> 2) + 4 * n + (i & 3); }

struct Unit { int pm, pn; };
struct Gemm { const bf16_t* A; const bf16_t* Bt; int M, N, K; };

struct StaticOrder {
    int nM, nN, nwg, G, c;
    __host__ __device__ void init(int M, int N, int G_, int c_) { nM = M / BM; nN = N / BM; nwg = nM * nN; G = G_; c = c_; }
    __host__ __device__ bool next(int i, Unit& u) const {
        const long L = (long)i * G + c; if (L >= nwg) return false;
        int wgid = (int)L; { const int q = nwg / NXCD, r = nwg % NXCD, xcd = wgid % NXCD, off = wgid / NXCD; wgid = (xcd < r ? xcd * (q + 1) : r * (q + 1) + (xcd - r) * q) + off; }
        const int nig = WGM * nN, gid = wgid / nig, fm = gid * WGM, gsz = (nM - fm) < WGM ? (nM - fm) : WGM;
        u.pm = fm + ((wgid % nig) % gsz); u.pn = (wgid % nig) / gsz; return true;
    }
    __device__ __forceinline__ void a_ready(const Unit&) const {}
    __device__ __forceinline__ void done(const Unit&) const {}
};
typedef __bf16 bf16x2_t __attribute__((ext_vector_type(2)));
__device__ __forceinline__ unsigned cvt_pk_bf16(float lo, float hi) { const float __attribute__((ext_vector_type(2))) v = {lo, hi}; return __builtin_bit_cast(unsigned, __builtin_convertvector(v, bf16x2_t)); }
typedef float f32x2 __attribute__((ext_vector_type(2)));
__device__ __forceinline__ f32x2 gelu_pk(f32x2 v) {
    const f32x2 av = __builtin_elementwise_abs(v), d = av * 0.2316418882f + 1.0f;
    f32x2 t; t.x = __builtin_amdgcn_rcpf(d.x); t.y = __builtin_amdgcn_rcpf(d.y);
    f32x2 q = t * 0.5307027145f + (-0.7265760135f); q = q * t + 0.7107068705f; q = q * t + (-0.142248368f); q = q * t + 0.127414796f; q = q * t;
    const f32x2 s = (v * v) * (-0.72134752044f);
    f32x2 e; e.x = __builtin_amdgcn_exp2f(s.x); e.y = __builtin_amdgcn_exp2f(s.y);
    const f32x2 m = v * (q * e), r = v - m;
    f32x2 o; o.x = v.x < 0.f ? m.x : r.x; o.y = v.y < 0.f ? m.y : r.y; return o;
}
template <class Epi, class Sched, bool ALIGN_EPI = false, bool SP2 = false>
__device__ __forceinline__ void gemm_phase(PG8_LAS unsigned char* lds, const Gemm g, const Sched& S, const Epi& E) {
    int tid_ = threadIdx.x; asm volatile("" : "+v"(tid_));
    const int tid = tid_, wid = __builtin_amdgcn_readfirstlane(tid >> 6), lane = tid & 63, wr = wid >> 2, wc = wid & 3, fr = lane & 15, fq = lane >> 4;
    const int K = g.K, nt = K / BK;
    unsigned voffA[2], voffB[2];
#pragma unroll
    for (int i = 0; i < 2; ++i) { int R, C; stage_rc(tid * 16 + i * 8192, R, C); const int Rb = Epi::PERM ? ((R & ~31) + perm32(R & 31)) : R;
        voffA[i] = (unsigned)(R * K + C) * 2u; voffB[i] = (unsigned)(Rb * K + C) * 2u; }
    const size_t kstep = (size_t)(BK * 2);
    const size_t hstep = (size_t)HALF * K * 2;
    const size_t tstep = 2 * hstep;
    const unsigned ldsw = (unsigned)wid * 1024u;
    const int aoff = lds_byte(wr * 64 + fr, fq * 8), boff = lds_byte(wc * 32 + fr, fq * 8);
#define PG8_SA(b, h) (((b) * 2 + (h)) * HTB)
#define PG8_SB(b, h) ((4 + (b) * 2 + (h)) * HTB)
#define PG8_STAGE(bufoff, gbase, voff) do { _Pragma("unroll") for (int _i = 0; _i < 2; ++_i) \
        __builtin_amdgcn_global_load_lds((const unsigned*)((const char*)(gbase) + (voff)[_i]), (PG8_LAS unsigned*)(lds + (bufoff) + ldsw + _i * 8192), 16, 0, 0); } while (0)
#define PG8_LDA(dst, b, h) do { _Pragma("unroll") for (int m = 0; m < 4; ++m) _Pragma("unroll") for (int k = 0; k < 2; ++k) dst[m][k] = *(const PG8_LAS bf16x8*)(lds + PG8_SA(b, h) + aoff + m * 2048 + k * 1024); } while (0)
#define PG8_LDB(dst, b, h) do { _Pragma("unroll") for (int n = 0; n < 2; ++n) _Pragma("unroll") for (int k = 0; k < 2; ++k) dst[n][k] = *(const PG8_LAS bf16x8*)(lds + PG8_SB(b, h) + boff + n * 2048 + k * 1024); } while (0)
#define PG8_MMA(ai, bj, At, Bt) do { __builtin_amdgcn_s_setprio(1); _Pragma("unroll") for (int m = 0; m < 4; ++m) _Pragma("unroll") for (int n = 0; n < 2; ++n) _Pragma("unroll") for (int k = 0; k < 2; ++k) \
        acc[ai][bj][m][n] = __builtin_amdgcn_mfma_f32_16x16x32_bf16(Bt[n][k], At[m][k], acc[ai][bj][m][n], 0, 0, 0); __builtin_amdgcn_s_setprio(0); } while (0)
#define PG8_WAIT_V(n) asm volatile("s_waitcnt vmcnt(" #n ")" ::: "memory")
#define PG8_WAIT_L(n) asm volatile("s_waitcnt lgkmcnt(" #n ")" ::: "memory")
#define PG8_BAR __builtin_amdgcn_s_barrier()
#define PG8_SCHED __builtin_amdgcn_sched_barrier(0)
    Unit cur, nxt; int ui = 0;
    if (!S.next(0, cur)) return;
    f32x4 acc[2][2][4][2];
#pragma unroll
    for (int a = 0; a < 2; ++a)
#pragma unroll
        for (int b = 0; b < 2; ++b)
#pragma unroll
            for (int m = 0; m < 4; ++m)
#pragma unroll
                for (int n = 0; n < 2; ++n) acc[a][b][m][n] = (f32x4){0.f, 0.f, 0.f, 0.f};
    bf16x8 At[4][2], B0[2][2], B1[2][2];
    const char* cA = (const char*)g.A + (size_t)cur.pm * tstep; const char* cB = (const char*)g.Bt + (size_t)cur.pn * tstep;
    S.a_ready(cur);
    if constexpr (SP2) {
        PG8_STAGE(PG8_SB(0, 0), cB, voffB); PG8_STAGE(PG8_SB(0, 1), cB + hstep, voffB); PG8_STAGE(PG8_SA(0, 0), cA, voffA); PG8_STAGE(PG8_SA(0, 1), cA + hstep, voffA);
        if (wr == 1) PG8_BAR;
        PG8_WAIT_V(2); PG8_BAR;
        PG8_STAGE(PG8_SB(1, 0), cB + kstep, voffB); PG8_STAGE(PG8_SA(1, 0), cA + kstep, voffA); PG8_STAGE(PG8_SB(1, 1), cB + hstep + kstep, voffB);
        PG8_WAIT_V(6); PG8_BAR;
    } else {
        PG8_STAGE(PG8_SB(0, 0), cB, voffB); PG8_STAGE(PG8_SA(0, 0), cA, voffA); PG8_STAGE(PG8_SB(0, 1), cB + hstep, voffB); PG8_STAGE(PG8_SA(0, 1), cA + hstep, voffA);
        if (wr == 1) PG8_BAR;
        PG8_WAIT_V(4); PG8_BAR;
        PG8_STAGE(PG8_SB(1, 0), cB + kstep, voffB); PG8_STAGE(PG8_SA(1, 0), cA + kstep, voffA); PG8_STAGE(PG8_SB(1, 1), cB + hstep + kstep, voffB);
        PG8_WAIT_V(6); PG8_BAR;
    }
    for (;;) {
        const bool has_next = S.next(ui + 1, nxt);
        const char* nA = has_next ? (const char*)g.A + (size_t)nxt.pm * tstep : cA; const char* nB = has_next ? (const char*)g.Bt + (size_t)nxt.pn * tstep : cB;
        for (int t = 0; t < nt; t += 2) {
            const bool last = (t == nt - 2);
            const char* a1 = cA + (size_t)(t + 1) * kstep;
            const char* a2 = last ? nA : cA + (size_t)(t + 2) * kstep; const char* b2 = last ? nB : cB + (size_t)(t + 2) * kstep;
            const char* a3 = a2 + kstep; const char* b3 = b2 + kstep;
            if (last && has_next) S.a_ready(nxt);
            if constexpr (SP2) {
            PG8_LDB(B0, 0, 0); PG8_LDB(B1, 0, 1); PG8_SCHED; PG8_LDA(At, 0, 0); PG8_STAGE(PG8_SA(1, 1), a1 + hstep, voffA);
            PG8_WAIT_V(8); PG8_WAIT_L(0); PG8_BAR; PG8_MMA(0, 0, At, B0); PG8_MMA(0, 1, At, B1); PG8_BAR; PG8_SCHED;
            PG8_LDA(At, 0, 1); PG8_STAGE(PG8_SB(0, 0), b2, voffB); PG8_STAGE(PG8_SB(0, 1), b2 + hstep, voffB); PG8_STAGE(PG8_SA(0, 0), a2, voffA);
            PG8_WAIT_V(8); PG8_WAIT_L(0); PG8_BAR; PG8_MMA(1, 0, At, B0); PG8_MMA(1, 1, At, B1); PG8_BAR; PG8_SCHED;
            PG8_LDB(B0, 1, 0); PG8_LDB(B1, 1, 1); PG8_SCHED; PG8_LDA(At, 1, 0); PG8_STAGE(PG8_SA(0, 1), a2 + hstep, voffA);
            PG8_WAIT_V(8); PG8_WAIT_L(0); PG8_BAR; PG8_MMA(0, 0, At, B0); PG8_MMA(0, 1, At, B1); PG8_BAR; PG8_SCHED;
            PG8_LDA(At, 1, 1); PG8_STAGE(PG8_SB(1, 0), b3, voffB); PG8_STAGE(PG8_SB(1, 1), b3 + hstep, voffB); PG8_STAGE(PG8_SA(1, 0), a3, voffA);
            PG8_WAIT_V(8); PG8_WAIT_L(0); PG8_BAR; PG8_MMA(1, 0, At, B0); PG8_MMA(1, 1, At, B1); PG8_BAR; PG8_SCHED;
            } else {
            PG8_LDB(B0, 0, 0); PG8_SCHED; PG8_LDA(At, 0, 0); PG8_STAGE(PG8_SA(1, 1), a1 + hstep, voffA);
            PG8_WAIT_L(8); PG8_BAR; PG8_WAIT_L(0); PG8_MMA(0, 0, At, B0); PG8_BAR; PG8_SCHED;
            PG8_LDB(B1, 0, 1); PG8_STAGE(PG8_SB(0, 0), b2, voffB);
            PG8_BAR; PG8_WAIT_L(0); PG8_MMA(0, 1, At, B1); PG8_BAR;
            PG8_LDA(At, 0, 1); PG8_STAGE(PG8_SA(0, 0), a2, voffA);
            PG8_BAR; PG8_WAIT_L(0); PG8_MMA(1, 0, At, B0); PG8_BAR; PG8_SCHED;
            PG8_STAGE(PG8_SB(0, 1), b2 + hstep, voffB);
            PG8_WAIT_V(6); PG8_BAR; PG8_MMA(1, 1, At, B1); PG8_BAR;
            PG8_LDB(B0, 1, 0); PG8_SCHED; PG8_LDA(At, 1, 0); PG8_STAGE(PG8_SA(0, 1), a2 + hstep, voffA);
            PG8_WAIT_L(8); PG8_BAR; PG8_WAIT_L(0); PG8_MMA(0, 0, At, B0); PG8_BAR; PG8_SCHED;
            PG8_LDB(B1, 1, 1); PG8_STAGE(PG8_SB(1, 0), b3, voffB);
            PG8_BAR; PG8_WAIT_L(0); PG8_MMA(0, 1, At, B1); PG8_BAR;
            PG8_LDA(At, 1, 1); PG8_STAGE(PG8_SA(1, 0), a3, voffA);
            PG8_BAR; PG8_WAIT_L(0); PG8_MMA(1, 0, At, B0); PG8_BAR; PG8_SCHED;
            PG8_STAGE(PG8_SB(1, 1), b3 + hstep, voffB);
            PG8_WAIT_V(6); PG8_BAR; PG8_MMA(1, 1, At, B1); PG8_BAR;
            }
        }
        if constexpr (ALIGN_EPI) { if (wr == 0) PG8_BAR; }
        if constexpr (!Epi::AFTER_DRAIN) { E(acc, cur, wr, wc, fr, fq); S.done(cur); }
        if (!has_next) break;
#pragma unroll
        for (int a = 0; a < 2; ++a)
#pragma unroll
            for (int b = 0; b < 2; ++b)
#pragma unroll
                for (int m = 0; m < 4; ++m)
#pragma unroll
                    for (int n = 0; n < 2; ++n) acc[a][b][m][n] = (f32x4){0.f, 0.f, 0.f, 0.f};
        cur = nxt; cA = nA; cB = nB; ++ui;
        if constexpr (ALIGN_EPI) { if (wr == 1) PG8_BAR; }
    }
    PG8_WAIT_V(0);
    if constexpr (!ALIGN_EPI) { if (wr == 0) PG8_BAR; }
    PG8_BAR;
    if constexpr (Epi::AFTER_DRAIN) { E.fused(acc, cur, wr, wc, fr, fq, lds, wid, lane); S.done(cur); }
#undef PG8_SA
#undef PG8_SB
#undef PG8_STAGE
#undef PG8_LDA
#undef PG8_LDB
#undef PG8_MMA
#undef PG8_WAIT_V
#undef PG8_WAIT_L
#undef PG8_BAR
#undef PG8_SCHED
}
}

constexpr int T = 16384, SEQ = 4096, DM = 2048, DFF = 5632, AW = 1536, NIN = 11776, NWAVES = 8;
constexpr int LDS_BYTES = 147456;

#define LAS __attribute__((address_space(3)))
typedef unsigned short bf16;
typedef float f32x4 __attribute__((ext_vector_type(4)));
typedef float f32x2 __attribute__((ext_vector_type(2)));
typedef unsigned u32x4 __attribute__((ext_vector_type(4)));
typedef unsigned u32x2 __attribute__((ext_vector_type(2)));
typedef short bf16x8 __attribute__((ext_vector_type(8)));
typedef short s16x4 __attribute__((ext_vector_type(4)));

constexpr size_t SZ_TA = (size_t)T * AW * 2;
constexpr size_t SZ_TD = (size_t)T * DM * 2;
constexpr size_t OFF_WIN = 0;
constexpr size_t OFF_WAO = OFF_WIN + (size_t)NIN * DM * 2;
constexpr size_t OFF_WSO = OFF_WAO + (size_t)DM * 512 * 2;
constexpr size_t OFF_WO  = OFF_WSO + (size_t)DM * AW * 2;
constexpr size_t OFF_H   = OFF_WO + (size_t)DM * DM * 2;
constexpr size_t OFF_STATS = OFF_H + SZ_TD;
constexpr size_t OFF_ML  = OFF_STATS + (size_t)T * 24 * 8;
constexpr size_t OFF_ROPE = OFF_ML + (size_t)3 * T * 4 * 8;
constexpr size_t OFF_SSQ = OFF_ROPE + (size_t)SEQ * 16 * 2 * 4;
constexpr size_t OFF_Z   = OFF_SSQ + (size_t)T * 32 * 4;
constexpr size_t ZGA = 0, ZGS = SZ_TD, ZQ = 2 * SZ_TD, ZK = ZQ + SZ_TA, ZV = ZQ + 2 * SZ_TA, ZGV = ZQ + 3 * SZ_TA, ZU = ZQ + 4 * SZ_TA, ZEND = ZQ + 5 * SZ_TA;
constexpr size_t ZACT = 0, ZTMP = ZQ, ZMRG = ZQ + SZ_TD, ZWGU = ZGV, ZWD = ZWGU + (size_t)2 * DFF * DM * 2;
constexpr size_t OFF_CTL = OFF_Z + ZEND;
constexpr size_t WS_NEED = OFF_CTL + 4096;
static_assert((size_t)T * DFF * 2 <= ZWGU && ZWD + (size_t)DM * DFF * 2 <= ZEND && ZMRG + SZ_TD <= ZWGU, "ws overlay map");

struct Params {
    const float* in[19];
    float* out;
    unsigned char* ws;
    float inv_freq[16];
};

__device__ __forceinline__ unsigned pk2(float lo, float hi) { return pg8::cvt_pk_bf16(lo, hi); }
__device__ __forceinline__ float bflo(unsigned w) { return __uint_as_float(w << 16); }
__device__ __forceinline__ float bfhi(unsigned w) { return __uint_as_float(w & 0xffff0000u); }
__device__ __forceinline__ float wave_sum(float v) {
#pragma unroll
    for (int o = 1; o < 64; o <<= 1) v += __shfl_xor(v, o);
    return v;
}
__device__ __forceinline__ float fast_sigmoid(float x) { return __builtin_amdgcn_rcpf(1.0f + __builtin_amdgcn_exp2f(-1.4426950408889634f * x)); }
__device__ __forceinline__ f32x4 gelu4(f32x4 v) {
    const f32x2 a = pg8::gelu_pk((f32x2){v[0], v[1]}), b = pg8::gelu_pk((f32x2){v[2], v[3]});
    return (f32x4){a.x, a.y, b.x, b.y};
}
__device__ __forceinline__ u32x4 pack8(f32x4 v0, f32x4 v1) { u32x4 w; w.x = pk2(v0[0], v0[1]); w.y = pk2(v0[2], v0[3]); w.z = pk2(v1[0], v1[1]); w.w = pk2(v1[2], v1[3]); return w; }

typedef pg8::Unit Unit;
struct EpiSwiGLU {
    static constexpr bool PERM = true, AFTER_DRAIN = false;
    bf16* O; const LAS float* rt;
    __device__ __forceinline__ void operator()(const f32x4 (&acc)[2][2][4][2], const Unit& u, int wr, int wc, int fr, int fq) const {
        const int row0 = u.pm * 256 + wr * 64 + fr, col0 = u.pn * 128 + wc * 32 + 8 * fq;
#pragma unroll
        for (int ai = 0; ai < 2; ++ai)
#pragma unroll
            for (int m = 0; m < 4; ++m) {
                bf16* rowp = O + (size_t)(row0 + ai * 128 + m * 16) * DFF + col0;
                const float rr = rt[ai * 128 + wr * 64 + m * 16 + fr];
                f32x4 a, b;
#pragma unroll
                for (int j = 0; j < 4; ++j) {
                    const float g0 = acc[ai][0][m][0][j] * rr, g1 = acc[ai][0][m][1][j] * rr;
                    a[j] = g0 * fast_sigmoid(g0) * (acc[ai][1][m][0][j] * rr);
                    b[j] = g1 * fast_sigmoid(g1) * (acc[ai][1][m][1][j] * rr);
                }
                *(u32x4*)rowp = pack8(a, b);
            }
    }
};
struct EpiResid {
    static constexpr bool PERM = false, AFTER_DRAIN = false;
    const float* R; float* O; float scale;
    __device__ __forceinline__ void operator()(const f32x4 (&acc)[2][2][4][2], const Unit& u, int wr, int wc, int fr, int fq) const {
        const int row0 = u.pm * 256 + wr * 64 + fr, col0 = u.pn * 256 + wc * 32 + 4 * fq;
#pragma unroll
        for (int ai = 0; ai < 2; ++ai)
#pragma unroll
            for (int m = 0; m < 4; ++m) {
                const size_t off = (size_t)(row0 + ai * 128 + m * 16) * DM + col0;
#pragma unroll
                for (int bj = 0; bj < 2; ++bj)
#pragma unroll
                    for (int n = 0; n < 2; ++n) {
                        const f32x4 r = *(const f32x4*)(R + off + bj * 128 + n * 16);
                        *(f32x4*)(O + off + bj * 128 + n * 16) = r + scale * acc[ai][bj][m][n];
                    }
            }
    }
};
template <bool NT_R  > struct EpiResidN {
    static constexpr bool PERM = false, AFTER_DRAIN = false;
    const float* R; float* O; float scale; const float* gn; bf16* A2; float* ssq;
    __device__ __forceinline__ void operator()(const f32x4 (&acc)[2][2][4][2], const Unit& u, int wr, int wc, int fr, int fq) const {
        const int row0 = u.pm * 256 + wr * 64 + fr, col0 = u.pn * 256 + wc * 32 + 4 * fq;
        f32x4 gv[2][2];
#pragma unroll
        for (int bj = 0; bj < 2; ++bj)
#pragma unroll
            for (int n = 0; n < 2; ++n) gv[bj][n] = *(const f32x4*)(gn + col0 + bj * 128 + n * 16);
#pragma unroll
        for (int ai = 0; ai < 2; ++ai)
#pragma unroll
            for (int m = 0; m < 4; ++m) {
                const int row = row0 + ai * 128 + m * 16;
                const size_t off = (size_t)row * DM + col0;
                float s = 0.f;
#pragma unroll
                for (int bj = 0; bj < 2; ++bj)
#pragma unroll
                    for (int n = 0; n < 2; ++n) {
                        const f32x4 r = NT_R ? __builtin_nontemporal_load((const f32x4*)(R + off + bj * 128 + n * 16)) : *(const f32x4*)(R + off + bj * 128 + n * 16);
                        const f32x4 o = r + scale * acc[ai][bj][m][n];
                        *(f32x4*)(O + off + bj * 128 + n * 16) = o;
                        s += (o[0] * o[0] + o[1] * o[1]) + (o[2] * o[2] + o[3] * o[3]);
                        const f32x4 w = o * gv[bj][n];
                        u32x2 pw; pw.x = pk2(w[0], w[1]); pw.y = pk2(w[2], w[3]);
                        *(u32x2*)(A2 + off + bj * 128 + n * 16) = pw;
                    }
                s += __shfl_xor(s, 16); s += __shfl_xor(s, 32);
                if (fq == 0) ssq[(size_t)row * 32 + u.pn * 4 + wc] = s;
            }
    }
};
struct EpiWin {
    static constexpr bool PERM = true, AFTER_DRAIN = false;
    bf16 *Q, *Kb, *V, *U, *GV, *GA, *GS; f32x2* stats; const float *cosT, *sinT; const LAS float* rt;
    __device__ __forceinline__ void operator()(const f32x4 (&acc)[2][2][4][2], const Unit& u, int wr, int wc, int fr, int fq) const {
        const int pn = (NIN / 256 - 1) - u.pn, row0 = u.pm * 256 + wr * 64 + fr, cw = wc * 32 + 8 * fq;
        if (pn < 18) {
            bf16* base = Q + (size_t)(pn / 6) * ((size_t)T * AW);
            const int colt = (pn % 6) * 256 + cw;
            const bool rope = (pn < 12) && (wc == 0);
            const float sgn = fq < 2 ? -1.f : 1.f;
#pragma unroll
            for (int ai = 0; ai < 2; ++ai)
#pragma unroll
                for (int m = 0; m < 4; ++m) {
                    const int row = row0 + ai * 128 + m * 16, pos = row & (SEQ - 1);
                    const float rr = rt[ai * 128 + wr * 64 + m * 16 + fr];
#pragma unroll
                    for (int bj = 0; bj < 2; ++bj) {
                        f32x4 v0 = acc[ai][bj][m][0] * rr, v1 = acc[ai][bj][m][1] * rr;
                        if (rope) {
                            f32x4 p0, p1;
#pragma unroll
                            for (int j = 0; j < 4; ++j) { p0[j] = __shfl_xor(v0[j], 32); p1[j] = __shfl_xor(v1[j], 32); }
                            const int i0 = pos * 16 + 8 * (fq & 1);
                            const f32x4 c0 = *(const f32x4*)(cosT + i0), c1 = *(const f32x4*)(cosT + i0 + 4);
                            const f32x4 s0 = *(const f32x4*)(sinT + i0), s1 = *(const f32x4*)(sinT + i0 + 4);
                            v0 = v0 * c0 + sgn * (p0 * s0); v1 = v1 * c1 + sgn * (p1 * s1);
                        }
                        *(u32x4*)(base + (size_t)row * AW + colt + bj * 128) = pack8(v0, v1);
                    }
                }
        } else if (pn < 24) {
            const int colt = (pn - 18) * 256 + cw;
#pragma unroll
            for (int ai = 0; ai < 2; ++ai)
#pragma unroll
                for (int m = 0; m < 4; ++m) {
                    const int row = row0 + ai * 128 + m * 16;
                    const float rr = rt[ai * 128 + wr * 64 + m * 16 + fr];
#pragma unroll
                    for (int bj = 0; bj < 2; ++bj)
                        *(u32x4*)(U + (size_t)row * AW + colt + bj * 128) = pack8(gelu4(acc[ai][bj][m][0] * rr), gelu4(acc[ai][bj][m][1] * rr));
                }
        } else if (pn < 30) {
            const int colt = (pn - 24) * 256 + cw;
#pragma unroll
            for (int ai = 0; ai < 2; ++ai)
#pragma unroll
                for (int m = 0; m < 4; ++m) {
                    const int row = row0 + ai * 128 + m * 16;
                    float s = 0.f, ss = 0.f;
                    const float rr = rt[ai * 128 + wr * 64 + m * 16 + fr];
#pragma unroll
                    for (int bj = 0; bj < 2; ++bj) {
                        const f32x4 a = gelu4(acc[ai][bj][m][0] * rr), b = gelu4(acc[ai][bj][m][1] * rr);
                        s += (a[0] + a[1]) + (a[2] + a[3]) + (b[0] + b[1]) + (b[2] + b[3]);
                        ss += (a[0] * a[0] + a[1] * a[1]) + (a[2] * a[2] + a[3] * a[3]) + (b[0] * b[0] + b[1] * b[1]) + (b[2] * b[2] + b[3] * b[3]);
                        *(u32x4*)(GV + (size_t)row * AW + colt + bj * 128) = pack8(a, b);
                    }
                    s += __shfl_xor(s, 16); s += __shfl_xor(s, 32);
                    ss += __shfl_xor(ss, 16); ss += __shfl_xor(ss, 32);
                    if (fq == 0) stats[(size_t)row * 24 + (pn - 24) * 4 + wc] = (f32x2){s, ss};
                }
        } else {
            bf16* base = GA + (size_t)(pn < 38 ? 0 : 1) * ((size_t)T * DM);
            const int colt = (pn < 38 ? pn - 30 : pn - 38) * 256 + cw;
#pragma unroll
            for (int ai = 0; ai < 2; ++ai)
#pragma unroll
                for (int m = 0; m < 4; ++m) {
                    const int row = row0 + ai * 128 + m * 16;
                    const float rr = rt[ai * 128 + wr * 64 + m * 16 + fr];
#pragma unroll
                    for (int bj = 0; bj < 2; ++bj) {
                        f32x4 a = acc[ai][bj][m][0] * rr, b = acc[ai][bj][m][1] * rr;
#pragma unroll
                        for (int j = 0; j < 4; ++j) { a[j] = fast_sigmoid(a[j]); b[j] = fast_sigmoid(b[j]); }
                        *(u32x4*)(base + (size_t)row * DM + colt + bj * 128) = pack8(a, b);
                    }
                }
        }
    }
};
template <int MODE> struct EpiGate {
    static constexpr bool PERM = true, AFTER_DRAIN = false;
    const bf16* G; const bf16* P; bf16* O;
    __device__ __forceinline__ void operator()(const f32x4 (&acc)[2][2][4][2], const Unit& u, int wr, int wc, int fr, int fq) const {
        const int row0 = u.pm * 256 + wr * 64 + fr, col0 = u.pn * 256 + wc * 32 + 8 * fq;
#pragma unroll
        for (int ai = 0; ai < 2; ++ai)
#pragma unroll
            for (int m = 0; m < 4; ++m) {
                const size_t off = (size_t)(row0 + ai * 128 + m * 16) * DM + col0;
#pragma unroll
                for (int bj = 0; bj < 2; ++bj) {
                    const u32x4 g = *(const u32x4*)(G + off + bj * 128);
                    f32x4 a = acc[ai][bj][m][0], b = acc[ai][bj][m][1];
                    a[0] *= bflo(g.x); a[1] *= bfhi(g.x); a[2] *= bflo(g.y); a[3] *= bfhi(g.y);
                    b[0] *= bflo(g.z); b[1] *= bfhi(g.z); b[2] *= bflo(g.w); b[3] *= bfhi(g.w);
                    if (MODE == 1) {
                        const u32x4 t = *(const u32x4*)(P + off + bj * 128);
                        a[0] += bflo(t.x); a[1] += bfhi(t.x); a[2] += bflo(t.y); a[3] += bfhi(t.y);
                        b[0] += bflo(t.z); b[1] += bfhi(t.z); b[2] += bflo(t.w); b[3] += bfhi(t.w);
                    }
                    *(u32x4*)(O + off + bj * 128) = pack8(a, b);
                }
            }
    }
};

__device__ __forceinline__ float q6(float f) { unsigned u = __float_as_uint(f); u += 0xFFFFu + ((u >> 17) & 1u); u &= 0xFFFE0000u; return __uint_as_float(u); }
constexpr int TR_SCR = 64 * 65 * 4;
__device__ __forceinline__ void transpose_item(const float* W, int K, int N, bf16* WT, int k0, int n0, int drow0, LAS float* scr, int lane) {
    const int cq = lane & 15, rq = lane >> 4;
    f32x4 v[16];
#pragma unroll
    for (int i = 0; i < 16; ++i) v[i] = __builtin_nontemporal_load((const f32x4*)(W + (size_t)(k0 + 4 * i + rq) * N + n0 + 4 * cq));
#pragma unroll
    for (int i = 0; i < 16; ++i) { LAS float* d = scr + (4 * i + rq) * 65 + 4 * cq; d[0] = v[i][0]; d[1] = v[i][1]; d[2] = v[i][2]; d[3] = v[i][3]; }
    asm volatile("s_waitcnt lgkmcnt(0)" ::: "memory");
    const int c = lane & 7;
#pragma unroll
    for (int j = 0; j < 8; ++j) { const int n = (lane >> 3) + 8 * j; const LAS float* s = scr + (8 * c) * 65 + n;
        u32x4 o; o.x = pk2(q6(s[0 * 65]), q6(s[1 * 65])); o.y = pk2(q6(s[2 * 65]), q6(s[3 * 65])); o.z = pk2(q6(s[4 * 65]), q6(s[5 * 65])); o.w = pk2(q6(s[6 * 65]), q6(s[7 * 65]));
        *(u32x4*)(WT + (size_t)(drow0 + n) * K + k0 + 8 * c) = o; }
    asm volatile("s_waitcnt lgkmcnt(0)" ::: "memory");
}
__device__ __forceinline__ bool transpose_seg(int& it, const float* W, int K, int N, bf16* WT, int map, LAS float* scr, int lane) {
    const int nblk = N / 64, nitems = (K / 64) * nblk;
    if (it >= nitems) { it -= nitems; return false; }
    const int kb = it / nblk, nb = it % nblk, n0 = nb * 64;
    const int drow0 = map == 0 ? n0 : (map == 3 ? ((N / 256 - 1 - (n0 >> 8)) * 256 + (n0 & 255)) : ((n0 >> 7) * 256 + (n0 & 127) + (map == 2 ? 128 : 0)));
    transpose_item(W, K, N, WT, kb * 64, n0, drow0, scr, lane);
    return true;
}
__device__ __forceinline__ void rms_row_bf16(const float* xrow, const float* g, bf16* orow, int lane) {
    f32x4 v[8]; float s = 0.f;
#pragma unroll
    for (int j = 0; j < 8; ++j) { v[j] = __builtin_nontemporal_load((const f32x4*)xrow + j * 64 + lane);
        s += (v[j][0] * v[j][0] + v[j][1] * v[j][1]) + (v[j][2] * v[j][2] + v[j][3] * v[j][3]); }
    const float r = 1.0f / sqrtf(wave_sum(s) * (1.0f / DM) + 1e-6f);
#pragma unroll
    for (int j = 0; j < 8; ++j) { const f32x4 gg = ((const f32x4*)g)[j * 64 + lane]; const f32x4 o = v[j] * r * gg;
        u32x2 w; w.x = pk2(o[0], o[1]); w.y = pk2(o[2], o[3]); ((u32x2*)orow)[j * 64 + lane] = w; }
}
__device__ __forceinline__ void rms_row_f32(const float* xrow, const float* g, float* orow, int lane) {
    f32x4 v[8]; float s = 0.f;
#pragma unroll
    for (int j = 0; j < 8; ++j) { v[j] = ((const f32x4*)xrow)[j * 64 + lane]; s += (v[j][0] * v[j][0] + v[j][1] * v[j][1]) + (v[j][2] * v[j][2] + v[j][3] * v[j][3]); }
    const float r = 1.0f / sqrtf(wave_sum(s) * (1.0f / DM) + 1e-6f);
#pragma unroll
    for (int j = 0; j < 8; ++j) { const f32x4 gg = ((const f32x4*)g)[j * 64 + lane]; ((f32x4*)orow)[j * 64 + lane] = v[j] * r * gg; }
}
__device__ __forceinline__ void sincos_tab(double a, float& s, float& c) {
    const double kq = rint(a * 0.63661977236758134308);
    double r = fma(-kq, 1.57079632679489655800, a); r = fma(-kq, 6.12323399573676603587e-17, r);
    const int q = ((int)kq) & 3;
    const double r2 = r * r;
    const double sp = r * (1.0 + r2 * (-1.0 / 6.0 + r2 * (1.0 / 120.0 + r2 * (-1.0 / 5040.0 + r2 * (1.0 / 362880.0 + r2 * (-1.0 / 39916800.0 + r2 * (1.0 / 6227020800.0)))))));
    const double cp = 1.0 + r2 * (-0.5 + r2 * (1.0 / 24.0 + r2 * (-1.0 / 720.0 + r2 * (1.0 / 40320.0 + r2 * (-1.0 / 3628800.0 + r2 * (1.0 / 479001600.0 + r2 * (-1.0 / 87178291200.0)))))));
    const double sv = (q == 0) ? sp : (q == 1) ? cp : (q == 2) ? -sp : -cp;
    const double cv = (q == 0) ? cp : (q == 1) ? -sp : (q == 2) ? -cp : sp;
    s = (float)sv; c = (float)cv;
}

constexpr int KV_STRIDE = 272;
constexpr int ATT_V_OFF = 256 * KV_STRIDE;
__device__ __forceinline__ bf16x8 tr_pair(LAS unsigned char* p0, LAS unsigned char* p1) {
    const s16x4 a = __builtin_amdgcn_ds_read_tr16_b64_v4i16((LAS s16x4*)p0);
    const s16x4 b = __builtin_amdgcn_ds_read_tr16_b64_v4i16((LAS s16x4*)p1);
    return (bf16x8){a[0], a[1], a[2], a[3], b[0], b[1], b[2], b[3]};
}
struct AttnIdx { int grp, b, hh, r, n, dsh, colbase; };
__device__ __forceinline__ AttnIdx attn_decode(int item) {
    AttnIdx a; a.grp = item >> 9; a.b = (item >> 7) & 3; a.hh = (item >> 5) & 3; const int rb = item & 31;
    a.dsh = 2 * a.grp; const int nbsh = 5 - 2 * a.grp; a.r = rb >> nbsh; a.n = rb & ((1 << nbsh) - 1); a.colbase = (a.grp * 4 + a.hh) * 128; return a;
}
__device__ __forceinline__ void attn_fetch_block(const bf16* Kb, const bf16* Vb, const AttnIdx& a, int nb, int tid, u32x4 (&kv)[4], u32x4 (&vv)[4]) {
    const int c = tid & 15, r0 = tid >> 4;
#pragma unroll
    for (int it = 0; it < 4; ++it) {
        const int ri = nb * 128 + it * 32 + r0;
        const size_t row = (size_t)a.b * SEQ + (((size_t)ri << a.dsh) + a.r);
        kv[it] = *(const u32x4*)(Kb + row * AW + a.colbase + c * 8); vv[it] = *(const u32x4*)(Vb + row * AW + a.colbase + c * 8);
    }
}
__device__ __forceinline__ void attn_store_block(LAS unsigned char* lds, int half, int tid, const u32x4 (&kv)[4], const u32x4 (&vv)[4]) {
    const int c = tid & 15, r0 = tid >> 4;
#pragma unroll
    for (int it = 0; it < 4; ++it) {
        const int row = half * 128 + it * 32 + r0;
        *(LAS u32x4*)(lds + row * KV_STRIDE + c * 16) = kv[it]; *(LAS u32x4*)(lds + ATT_V_OFF + row * KV_STRIDE + c * 16) = vv[it];
    }
}
__device__ __forceinline__ void attn_zero_block(LAS unsigned char* lds, int half, int tid) {
    const u32x4 z = {0u, 0u, 0u, 0u}; u32x4 kz[4] = {z, z, z, z};
    attn_store_block(lds, half, tid, kz, kz);
}
__device__ __forceinline__ void attn_fetch_q(const bf16* Qb, const AttnIdx& a, int w, int lane, bf16x8 (&Qf)[4]) {
    const int qi = 16 * w + (lane & 15), g = lane >> 4;
    const size_t rowq = (size_t)a.b * SEQ + ((((size_t)a.n * 128 + qi) << a.dsh) + a.r);
#pragma unroll
    for (int ks = 0; ks < 4; ++ks) Qf[ks] = *(const bf16x8*)(Qb + rowq * AW + a.colbase + 32 * ks + 8 * g);
}
__device__ __forceinline__ void attn_range(const bf16* Qb, const bf16* Kb, const bf16* Vb, bf16* OG, f32x2* ML, LAS unsigned char* lds, int first, int count, int tid) {
    if (count <= 0) return;
    const int w = __builtin_amdgcn_readfirstlane(tid >> 6), lane = tid & 63, l15 = lane & 15, g = lane >> 4;
    LAS unsigned char* Kl = lds; LAS unsigned char* Vl = lds + ATT_V_OFF;
    AttnIdx a = attn_decode(first);
    bf16x8 Qf[4];
    {
        u32x4 kv[4], vv[4];
        if (a.n > 0) { attn_fetch_block(Kb, Vb, a, a.n - 1, tid, kv, vv); attn_store_block(lds, (a.n - 1) & 1, tid, kv, vv); }
        else attn_zero_block(lds, 1, tid);
        attn_fetch_block(Kb, Vb, a, a.n, tid, kv, vv); attn_store_block(lds, a.n & 1, tid, kv, vv);
        attn_fetch_q(Qb, a, w, lane, Qf);
    }
    __syncthreads();
    for (int s = 0; s < count; ++s) {
        const bool has_next = (s + 1 < count);
        AttnIdx an = attn_decode(has_next ? first + s + 1 : first + s);
        u32x4 nkv[4], nvv[4]; bf16x8 nQ[4];
        if (has_next) { attn_fetch_block(Kb, Vb, an, an.n, tid, nkv, nvv); attn_fetch_q(Qb, an, w, lane, nQ); }
        const int n = a.n, hc = n & 1, hp = hc ^ 1;
        const int qi = 16 * w + l15;
        const size_t rowq = (size_t)a.b * SEQ + ((((size_t)n * 128 + qi) << a.dsh) + a.r);
        const int tb = w & ~1;
        f32x4 S[10];
#pragma unroll
        for (int tt = 0; tt < 10; ++tt) {
            S[tt] = (f32x4){0.f, 0.f, 0.f, 0.f};
            const int t = tb + tt, lrow = ((t < 8 ? hp : hc) * 128 + (t & 7) * 16 + l15);
#pragma unroll
            for (int ks = 0; ks < 4; ++ks) {
                const bf16x8 kf = *(const LAS bf16x8*)(Kl + lrow * KV_STRIDE + (32 * ks + 8 * g) * 2);
                S[tt] = __builtin_amdgcn_mfma_f32_16x16x32_bf16(kf, Qf[ks], S[tt], 0, 0, 0);
            }
        }
        const float sc = 0.08838834764831845f * 1.4426950408889634f;
        float mx = -INFINITY;
#pragma unroll
        for (int tt = 0; tt < 10; ++tt)
#pragma unroll
            for (int e = 0; e < 4; ++e) {
                const int kj = 16 * (tb + tt) + 4 * g + e;
                const bool valid = (kj >= qi) && (kj <= qi + 128) && (n > 0 || kj >= 128);
                const float sv = valid ? S[tt][e] * sc : -INFINITY;
                S[tt][e] = sv; mx = fmaxf(mx, sv);
            }
        mx = fmaxf(mx, __shfl_xor(mx, 16)); mx = fmaxf(mx, __shfl_xor(mx, 32));
        float l = 0.f;
#pragma unroll
        for (int tt = 0; tt < 10; ++tt)
#pragma unroll
            for (int e = 0; e < 4; ++e) { const float pv = __builtin_amdgcn_exp2f(S[tt][e] - mx); S[tt][e] = pv; l += pv; }
        l += __shfl_xor(l, 16); l += __shfl_xor(l, 32);
        f32x4 O[8];
#pragma unroll
        for (int dt = 0; dt < 8; ++dt) O[dt] = (f32x4){0.f, 0.f, 0.f, 0.f};
        const int qq = l15 >> 2, pp = lane & 3;
#pragma unroll
        for (int kp = 0; kp < 5; ++kp) {
            const u32x4 pw = pack8(S[2 * kp], S[2 * kp + 1]);
            const bf16x8 pf = __builtin_bit_cast(bf16x8, pw);
            const int t0 = tb + 2 * kp;
            LAS unsigned char* v0 = Vl + ((t0 < 8 ? hp : hc) * 128 + (t0 & 7) * 16 + 4 * g + qq) * KV_STRIDE + 8 * pp;
#pragma unroll
            for (int dt = 0; dt < 8; ++dt) {
                const bf16x8 vf = tr_pair(v0 + 32 * dt, v0 + 16 * KV_STRIDE + 32 * dt);
                O[dt] = __builtin_amdgcn_mfma_f32_16x16x32_bf16(vf, pf, O[dt], 0, 0, 0);
            }
        }
        const float inv = 1.0f / l;
        bf16* op = OG + ((size_t)a.grp * T + rowq) * 512 + a.hh * 128 + 4 * g;
#pragma unroll
        for (int dt = 0; dt < 8; ++dt) { const f32x4 o = O[dt] * inv; u32x2 wv; wv.x = pk2(o[0], o[1]); wv.y = pk2(o[2], o[3]); *(u32x2*)(op + 16 * dt) = wv; }
        if (g == 0) ML[((size_t)a.grp * T + rowq) * 4 + a.hh] = (f32x2){mx, l};
        __syncthreads();
        if (has_next) {
            attn_store_block(lds, an.n & 1, tid, nkv, nvv);
            if (an.n == 0) attn_zero_block(lds, 1, tid);
#pragma unroll
            for (int ks = 0; ks < 4; ++ks) Qf[ks] = nQ[ks];
            a = an;
            __syncthreads();
        }
    }
}

__device__ __forceinline__ void spatial_fetch_stats(const f32x2* stats, size_t t0, int tid, f32x2 (&sv)[24]) {
    if (tid < 128) { const f32x2* sp = stats + (t0 + tid) * 24;
#pragma unroll
        for (int j = 0; j < 24; ++j) sv[j] = sp[j]; }
}
__device__ __forceinline__ void spatial_put_stats(LAS f32x2* st, int tid, const f32x2 (&sv)[24]) {
    if (tid < 128) { float s = 0.f, ss = 0.f;
#pragma unroll
        for (int j = 0; j < 24; ++j) { s += sv[j].x; ss += sv[j].y; }
        const float mean = s * (1.0f / AW), var = fmaxf(ss * (1.0f / AW) - mean * mean, 0.f);
        st[tid] = (f32x2){mean, 1.0f / sqrtf(var + 1e-5f)}; }
}
__device__ __forceinline__ void spatial_fetch_gv(const bf16* GV, size_t t0, int g, int tid, u32x4 (&gv)[4]) {
    const int c = tid & 15, r0 = tid >> 4;
#pragma unroll
    for (int it = 0; it < 4; ++it) gv[it] = *(const u32x4*)(GV + (t0 + it * 32 + r0) * AW + g * 128 + c * 8);
}
__device__ __forceinline__ void spatial_range(const bf16* GV, bf16* U, const f32x2* stats, const float* lng, const float* lnb, const float* sgw, const float* sgb,
                                              LAS unsigned char* lds, int first, int count, int tid) {
    if (count <= 0) return;
    const int w = __builtin_amdgcn_readfirstlane(tid >> 6), lane = tid & 63, l15 = lane & 15, gq = lane >> 4;
    LAS unsigned char* Yl = lds; LAS f32x2* stb = (LAS f32x2*)(lds + 128 * KV_STRIDE);
    const int t = 16 * w + l15, qq = l15 >> 2, pp = lane & 3, c = tid & 15, r0 = tid >> 4;
    int cur_g = -1; bf16x8 Wf[4]; f32x4 g0, g1, b0, b1; float bias = 0.f;
    f32x2 sv[24]; u32x4 gv[4];
    { const int g = first >> 7, ci = first & 127; spatial_fetch_stats(stats, (size_t)ci * 128, tid, sv); spatial_fetch_gv(GV, (size_t)ci * 128, g, tid, gv); spatial_put_stats(stb, tid, sv); }
    for (int s = 0; s < count; ++s) {
        const int item = first + s, g = item >> 7, ci = item & 127;
        const size_t t0 = (size_t)ci * 128;
        LAS f32x2* st = stb + (s & 1) * 128; LAS f32x2* stn = stb + ((s + 1) & 1) * 128;
        if (g != cur_g) {
            cur_g = g;
            g0 = *(const f32x4*)(lng + g * 128 + c * 8); g1 = *(const f32x4*)(lng + g * 128 + c * 8 + 4);
            b0 = *(const f32x4*)(lnb + g * 128 + c * 8); b1 = *(const f32x4*)(lnb + g * 128 + c * 8 + 4);
            bias = sgb[g * 128 + t];
#pragma unroll
            for (int ks = 0; ks < 4; ++ks) {
                const int s0 = 32 * ks + 8 * gq;
                const float* wp = sgw + ((size_t)(g * 128 + t)) * 128 + s0;
                f32x4 a = *(const f32x4*)wp, bb = *(const f32x4*)(wp + 4);
#pragma unroll
                for (int j = 0; j < 4; ++j) { if (s0 + j > t) a[j] = 0.f; if (s0 + 4 + j > t) bb[j] = 0.f; }
                Wf[ks] = __builtin_bit_cast(bf16x8, pack8(a, bb));
            }
        }
        __syncthreads();
#pragma unroll
        for (int it = 0; it < 4; ++it) {
            const int row = it * 32 + r0;
            const u32x4 v = gv[it];
            const f32x2 ms = st[row];
            f32x4 a = {bflo(v.x), bfhi(v.x), bflo(v.y), bfhi(v.y)}, bb = {bflo(v.z), bfhi(v.z), bflo(v.w), bfhi(v.w)};
            a = (a - ms.x) * ms.y * g0 + b0; bb = (bb - ms.x) * ms.y * g1 + b1;
            *(LAS u32x4*)(Yl + row * KV_STRIDE + c * 16) = pack8(a, bb);
        }
        bf16* up = U + (t0 + t) * AW + g * 128 + 4 * gq;
        u32x2 uv[8];
#pragma unroll
        for (int ct = 0; ct < 8; ++ct) uv[ct] = *(const u32x2*)(up + 16 * ct);
        const bool has_next = (s + 1 < count);
        if (has_next) { const int ni = item + 1, ng = ni >> 7, nci = ni & 127; spatial_fetch_stats(stats, (size_t)nci * 128, tid, sv); spatial_fetch_gv(GV, (size_t)nci * 128, ng, tid, gv); }
        __syncthreads();
        f32x4 acc[8];
#pragma unroll
        for (int ct = 0; ct < 8; ++ct) acc[ct] = (f32x4){0.f, 0.f, 0.f, 0.f};
#pragma unroll
        for (int ks = 0; ks < 4; ++ks) {
            if (ks <= (w >> 1)) {
                LAS unsigned char* y0 = Yl + (32 * ks + 8 * gq + qq) * KV_STRIDE + 8 * pp;
#pragma unroll
                for (int ct = 0; ct < 8; ++ct) {
                    const bf16x8 yf = tr_pair(y0 + 32 * ct, y0 + 4 * KV_STRIDE + 32 * ct);
                    acc[ct] = __builtin_amdgcn_mfma_f32_16x16x32_bf16(yf, Wf[ks], acc[ct], 0, 0, 0);
                }
            }
        }
#pragma unroll
        for (int ct = 0; ct < 8; ++ct) {
            const f32x4 a = acc[ct] + bias;
            u32x2 o; o.x = pk2(bflo(uv[ct].x) * a[0], bfhi(uv[ct].x) * a[1]); o.y = pk2(bflo(uv[ct].y) * a[2], bfhi(uv[ct].y) * a[3]);
            *(u32x2*)(up + 16 * ct) = o;
        }
        if (has_next) spatial_put_stats(stn, tid, sv);
    }
    __syncthreads();
}

__global__ void __launch_bounds__(NWAVES * 64, 2) mega_fwd(Params p) {
    extern __shared__ __attribute__((aligned(16))) unsigned char lds_raw[];
    LAS unsigned char* lds = (LAS unsigned char*)lds_raw;
    cg::grid_group grid = cg::this_grid();
    const int tid = threadIdx.x, lane = tid & 63, wave = __builtin_amdgcn_readfirstlane(tid >> 6);
    const int G = gridDim.x, bx = blockIdx.x;
    const int NGW = G * NWAVES;
    unsigned char* ws = p.ws;
    const float* x = p.in[0];
    bf16* WIN = (bf16*)(ws + OFF_WIN); bf16* WAO = (bf16*)(ws + OFF_WAO); bf16* WSO = (bf16*)(ws + OFF_WSO); bf16* WO = (bf16*)(ws + OFF_WO);
    bf16* H = (bf16*)(ws + OFF_H);
    bf16* OG = (bf16*)(ws + OFF_H); bf16* OATT = (bf16*)(ws + OFF_H + (size_t)3 * T * 512 * 2);
    f32x2* STATS = (f32x2*)(ws + OFF_STATS); f32x2* ML = (f32x2*)(ws + OFF_ML);
    float* COS = (float*)(ws + OFF_ROPE); float* SIN = COS + SEQ * 16;
    unsigned char* Z = ws + OFF_Z;
    bf16* QB = (bf16*)(Z + ZQ); bf16* KB = (bf16*)(Z + ZK); bf16* VB = (bf16*)(Z + ZV); bf16* GVB = (bf16*)(Z + ZGV); bf16* UB = (bf16*)(Z + ZU);
    bf16* GA = (bf16*)(Z + ZGA); bf16* GS = (bf16*)(Z + ZGS);
    bf16* ACT = (bf16*)(Z + ZACT); bf16* TMP = (bf16*)(Z + ZTMP); bf16* MRG = (bf16*)(Z + ZMRG);
    bf16* WGU = (bf16*)(Z + ZWGU); bf16* WD = (bf16*)(Z + ZWD);
    LAS float* scr = (LAS float*)(lds + wave * TR_SCR);

    unsigned* const gbar = (unsigned*)(ws + OFF_CTL);
    unsigned epoch = 0;
#define GRID_SYNC() do { asm volatile("s_waitcnt vmcnt(0) lgkmcnt(0)" ::: "memory"); __syncthreads(); \
        if (tid == 0) { __builtin_amdgcn_fence(__ATOMIC_RELEASE, "agent"); asm volatile("s_waitcnt vmcnt(0)" ::: "memory"); \
            __hip_atomic_fetch_add(gbar, 1u, __ATOMIC_RELAXED, __HIP_MEMORY_SCOPE_AGENT); \
            const unsigned target = (epoch + 1u) * (unsigned)G; \
            while (__hip_atomic_load(gbar, __ATOMIC_RELAXED, __HIP_MEMORY_SCOPE_AGENT) < target) __builtin_amdgcn_s_sleep(2); \
            __builtin_amdgcn_fence(__ATOMIC_ACQUIRE, "agent"); asm volatile("s_waitcnt vmcnt(0)" ::: "memory"); } \
        ++epoch; __syncthreads(); } while (0)
    if (bx == 0) for (int i = tid; i < 1024; i += NWAVES * 64) __hip_atomic_store(gbar + i, 0u, __ATOMIC_RELAXED, __HIP_MEMORY_SCOPE_AGENT);
    asm volatile("s_waitcnt vmcnt(0) lgkmcnt(0)" ::: "memory");
    grid.sync();
    if (wave == 0) { __builtin_amdgcn_fence(__ATOMIC_ACQUIRE, "agent"); asm volatile("s_waitcnt vmcnt(0)" ::: "memory"); }
    __syncthreads();
    const unsigned xcc = (unsigned)__builtin_amdgcn_s_getreg((3 << 11) | 20) & 0xFu;
    volatile LAS unsigned* misc = (volatile LAS unsigned*)(lds + 140288);
    if (tid == 0) misc[0] = __hip_atomic_fetch_add(gbar + 64 + 64 * (xcc & 7u), 1u, __ATOMIC_RELAXED, __HIP_MEMORY_SCOPE_AGENT);
    int vc = bx;
    int vcu = (G % 8 == 0) ? (bx % 8) * (G / 8) + bx / 8 : bx;
    int gw = vcu * NWAVES + wave;
    {
        constexpr int NIT = 3 * (DM / 64) * (DFF / 64) + (DM / 64) * (NIN / 64);
        for (int it0 = gw; it0 < NIT; it0 += NGW) {
            int it = it0;
            if (transpose_seg(it, p.in[2], DM, DFF, WGU, 1, scr, lane)) continue;
            if (transpose_seg(it, p.in[3], DM, DFF, WGU, 2, scr, lane)) continue;
            if (transpose_seg(it, p.in[4], DFF, DM, WD, 0, scr, lane)) continue;
            transpose_seg(it, p.in[6], DM, NIN, WIN, 3, scr, lane);
        }
        for (int pos = bx * 512 + tid; pos < SEQ; pos += G * 512) {
#pragma unroll
            for (int fi = 0; fi < 16; ++fi) {
                const float ang = (float)pos * p.inv_freq[fi];
                float s, c; sincos_tab((double)ang, s, c);
                COS[pos * 16 + fi] = c; SIN[pos * 16 + fi] = s;
            }
        }
        for (int m = gw; m < T; m += NGW) rms_row_bf16(x + (size_t)m * DM, p.in[1], H + (size_t)m * DM, lane);
    }
    GRID_SYNC();
    {
        if (tid == 0) {
            bool ok = (G % 8 == 0);
            for (int j = 0; j < 8; ++j) ok = ok && (__hip_atomic_load(gbar + 64 + 64 * j, __ATOMIC_RELAXED, __HIP_MEMORY_SCOPE_AGENT) == (unsigned)(G / 8));
            misc[1] = ok ? (misc[0] * 8u + (xcc & 7u)) : (unsigned)bx;
        }
        __syncthreads();
        vc = (int)misc[1];
        __syncthreads();
        vcu = (G % 8 == 0) ? (vc % 8) * (G / 8) + vc / 8 : vc;
        gw = vcu * NWAVES + wave;
    }
    LAS float* const rtab = (LAS float*)(lds + 131072 + 1024);
    float* const SSQ = (float*)(ws + OFF_SSQ);
#define FILL_RTAB(S_, FROM_SSQ) do { pg8::Unit u0_; (void)(S_).next(0, u0_); \
        if (tid < 256) { float r_ = 1.0f; \
            if (FROM_SSQ) { const f32x4* sp_ = (const f32x4*)(SSQ + (size_t)(u0_.pm * 256 + tid) * 32); float s_ = 0.f; \
                _Pragma("unroll") for (int j_ = 0; j_ < 8; ++j_) { const f32x4 v_ = sp_[j_]; s_ += (v_[0] + v_[1]) + (v_[2] + v_[3]); } \
                r_ = 1.0f / sqrtf(s_ * (1.0f / DM) + 1e-6f); } \
            rtab[tid] = r_; } \
        __syncthreads(); } while (0)
#define TILE_SYNC(S_, WORD0) do { pg8::Unit ut_; if (G == 256 && (S_).next(0, ut_)) { unsigned* const pc_ = gbar + (WORD0) + ut_.pm; \
        asm volatile("s_waitcnt vmcnt(0) lgkmcnt(0)" ::: "memory"); __syncthreads(); \
        if (tid == 0) { __builtin_amdgcn_fence(__ATOMIC_RELEASE, "agent"); asm volatile("s_waitcnt vmcnt(0)" ::: "memory"); \
            __hip_atomic_fetch_add(pc_, 1u, __ATOMIC_RELAXED, __HIP_MEMORY_SCOPE_AGENT); \
            while (__hip_atomic_load(pc_, __ATOMIC_RELAXED, __HIP_MEMORY_SCOPE_AGENT) < 4u) __builtin_amdgcn_s_sleep(2); \
            __builtin_amdgcn_fence(__ATOMIC_ACQUIRE, "agent"); asm volatile("s_waitcnt vmcnt(0)" ::: "memory"); } \
        __syncthreads(); } else { GRID_SYNC(); } } while (0)
    {
        pg8::Gemm g{H, WGU, T, 2 * DFF, DM}; pg8::StaticOrder S; S.init(T, 2 * DFF, G, vc);
        FILL_RTAB(S, false);
        EpiSwiGLU E{ACT, rtab};
        pg8::gemm_phase<EpiSwiGLU, pg8::StaticOrder, true, true>(lds, g, S, E);
        TILE_SYNC(S, 640);
    }
    {
        pg8::Gemm g{ACT, WD, T, DM, DFF}; pg8::StaticOrder S; S.init(T, DM, G, vc);
        EpiResidN<true> E{x, p.out, 0.5f, p.in[5], H, SSQ};
        pg8::gemm_phase<EpiResidN<true>, pg8::StaticOrder, true, true>(lds, g, S, E);
    }
    GRID_SYNC();
    {
        pg8::Gemm g{H, WIN, T, NIN, DM}; pg8::StaticOrder S; S.init(T, NIN, G, vc);
        FILL_RTAB(S, true);
        EpiWin E{QB, KB, VB, UB, GVB, GA, GS, STATS, COS, SIN, rtab};
        pg8::gemm_phase<EpiWin, pg8::StaticOrder, true, true>(lds, g, S, E);
        {
            const int nbusy = (G == 256) ? 128 : 0;
            if (vc >= nbusy) {
                constexpr int NIT3 = (512 / 64) * (DM / 64) + (AW / 64) * (DM / 64) + (DM / 64) * (DM / 64);
                for (int it0 = (vc - nbusy) * NWAVES + wave; it0 < NIT3; it0 += (G - nbusy) * NWAVES) {
                    int it = it0;
                    if (transpose_seg(it, p.in[11], 512, DM, WAO, 0, scr, lane)) continue;
                    if (transpose_seg(it, p.in[12], AW, DM, WSO, 0, scr, lane)) continue;
                    transpose_seg(it, p.in[13], DM, DM, WO, 0, scr, lane);
                }
            }
        }
    }
    GRID_SYNC();
    {
        const int per = (1536 + G - 1) / G, first = bx * per, cnt = (1536 - first) < per ? (1536 - first) : per;
        attn_range(QB, KB, VB, OG, ML, lds, first, cnt, tid);
        spatial_range(GVB, UB, STATS, p.in[7], p.in[8], p.in[9], p.in[10], lds, first, cnt, tid);
    }
    GRID_SYNC();
    {
        pg8::Gemm g{OATT, WAO, T, DM, 512}; pg8::StaticOrder S; S.init(T, DM, G, vc);
        { pg8::Unit u0;
          if (S.next(0, u0)) {
    for (int tok = u0.pm * 256 + wave; tok < u0.pm * 256 + 256; tok += NWAVES) {
                const int hh = lane >> 4;
                const f32x2 a0 = ML[((size_t)0 * T + tok) * 4 + hh], a1 = ML[((size_t)1 * T + tok) * 4 + hh], a2 = ML[((size_t)2 * T + tok) * 4 + hh];
                const float M = fmaxf(a0.x, fmaxf(a1.x, a2.x));
                const float w0 = a0.y * __builtin_amdgcn_exp2f(a0.x - M), w1 = a1.y * __builtin_amdgcn_exp2f(a1.x - M), w2 = a2.y * __builtin_amdgcn_exp2f(a2.x - M);
                const float inv = 1.0f / (w0 + w1 + w2);
                const u32x4 o0 = *(const u32x4*)(OG + ((size_t)0 * T + tok) * 512 + lane * 8), o1 = *(const u32x4*)(OG + ((size_t)1 * T + tok) * 512 + lane * 8),
                            o2 = *(const u32x4*)(OG + ((size_t)2 * T + tok) * 512 + lane * 8);
                f32x4 a, b;
                a[0] = w0 * bflo(o0.x) + w1 * bflo(o1.x) + w2 * bflo(o2.x); a[1] = w0 * bfhi(o0.x) + w1 * bfhi(o1.x) + w2 * bfhi(o2.x);
                a[2] = w0 * bflo(o0.y) + w1 * bflo(o1.y) + w2 * bflo(o2.y); a[3] = w0 * bfhi(o0.y) + w1 * bfhi(o1.y) + w2 * bfhi(o2.y);
                b[0] = w0 * bflo(o0.z) + w1 * bflo(o1.z) + w2 * bflo(o2.z); b[1] = w0 * bfhi(o0.z) + w1 * bfhi(o1.z) + w2 * bfhi(o2.z);
                b[2] = w0 * bflo(o0.w) + w1 * bflo(o1.w) + w2 * bflo(o2.w); b[3] = w0 * bfhi(o0.w) + w1 * bfhi(o1.w) + w2 * bfhi(o2.w);
                *(u32x4*)(OATT + (size_t)tok * 512 + lane * 8) = pack8(a * inv, b * inv);
            }
          }
          asm volatile("s_waitcnt vmcnt(0)" ::: "memory"); __syncthreads(); }
        EpiGate<0> E{GA, nullptr, TMP};
        pg8::gemm_phase<EpiGate<0>, pg8::StaticOrder, true, true>(lds, g, S, E);
    }
    {
        pg8::Gemm g{UB, WSO, T, DM, AW}; pg8::StaticOrder S; S.init(T, DM, G, vc);
        EpiGate<1> E{GS, TMP, MRG};
        pg8::gemm_phase<EpiGate<1>, pg8::StaticOrder, true, true>(lds, g, S, E);
    }
    GRID_SYNC();
    {
        constexpr int NIT = 3 * (DM / 64) * (DFF / 64);
        for (int it0 = gw; it0 < NIT; it0 += NGW) {
            int it = it0;
            if (transpose_seg(it, p.in[15], DM, DFF, WGU, 1, scr, lane)) continue;
            if (transpose_seg(it, p.in[16], DM, DFF, WGU, 2, scr, lane)) continue;
            transpose_seg(it, p.in[17], DFF, DM, WD, 0, scr, lane);
        }
        __syncthreads();
        pg8::Gemm g{MRG, WO, T, DM, DM}; pg8::StaticOrder S; S.init(T, DM, G, vc);
        EpiResidN<false> E{p.out, p.out, 1.0f, p.in[14], H, SSQ};
        pg8::gemm_phase<EpiResidN<false>, pg8::StaticOrder, true, true>(lds, g, S, E);
    }
    GRID_SYNC();
    {
        pg8::Gemm g{H, WGU, T, 2 * DFF, DM}; pg8::StaticOrder S; S.init(T, 2 * DFF, G, vc);
        FILL_RTAB(S, true);
        EpiSwiGLU E{ACT, rtab};
        pg8::gemm_phase<EpiSwiGLU, pg8::StaticOrder, true, true>(lds, g, S, E);
        TILE_SYNC(S, 704);
    }
    {
        pg8::Gemm g{ACT, WD, T, DM, DFF}; pg8::StaticOrder S; S.init(T, DM, G, vc);
        EpiResid E{p.out, p.out, 0.5f};
        pg8::gemm_phase<EpiResid, pg8::StaticOrder, true, true>(lds, g, S, E);
        pg8::Unit u0;
        if (G == 256 && S.next(0, u0)) {
            unsigned* const pc = gbar + 576 + u0.pm;
            asm volatile("s_waitcnt vmcnt(0) lgkmcnt(0)" ::: "memory"); __syncthreads();
            if (tid == 0) {
                __builtin_amdgcn_fence(__ATOMIC_RELEASE, "agent"); asm volatile("s_waitcnt vmcnt(0)" ::: "memory");
                misc[2] = __hip_atomic_fetch_add(pc, 1u, __ATOMIC_RELAXED, __HIP_MEMORY_SCOPE_AGENT);
                while (__hip_atomic_load(pc, __ATOMIC_RELAXED, __HIP_MEMORY_SCOPE_AGENT) < 4u) __builtin_amdgcn_s_sleep(2);
                __builtin_amdgcn_fence(__ATOMIC_ACQUIRE, "agent"); asm volatile("s_waitcnt vmcnt(0)" ::: "memory");
            }
            __syncthreads();
            const int q = (int)(misc[2] & 3u);
            for (int r = wave; r < 64; r += NWAVES) { const size_t m = (size_t)u0.pm * 256 + 64 * q + r; rms_row_f32(p.out + m * DM, p.in[18], p.out + m * DM, lane); }
        } else {
            GRID_SYNC();
            for (int m = gw; m < T; m += NGW) rms_row_f32(p.out + (size_t)m * DM, p.in[18], p.out + (size_t)m * DM, lane);
        }
    }
}

extern "C" void kernel_launch(void* const* d_in, const int* in_sizes, int n_in, void* d_out, int out_size, void* d_ws, size_t ws_size, hipStream_t stream) {
    static int grid = 0;
    if (grid == 0) {
        if (n_in != 19 || out_size != T * DM || ws_size < WS_NEED) { fprintf(stderr, "kernel_launch: unexpected shapes (n_in %d out %d ws %zu need %zu)\n", n_in, out_size, ws_size, (size_t)WS_NEED); grid = -1; return; }
        int dev = 0, cus = 0, per_cu = 0;
        (void)hipGetDevice(&dev); (void)hipDeviceGetAttribute(&cus, hipDeviceAttributeMultiprocessorCount, dev);
        if (hipFuncSetAttribute((const void*)mega_fwd, hipFuncAttributeMaxDynamicSharedMemorySize, LDS_BYTES) != hipSuccess) { fprintf(stderr, "kernel_launch: hipFuncSetAttribute failed\n"); }
        if (hipOccupancyMaxActiveBlocksPerMultiprocessor(&per_cu, (const void*)mega_fwd, NWAVES * 64, LDS_BYTES) != hipSuccess || per_cu < 1) per_cu = 1;
        (void)hipGetLastError();
        grid = cus * 1;
        if (grid <= 0) grid = 256;
    }
    if (grid < 0) return;
    Params p{};
    for (int i = 0; i < 19; ++i) p.in[i] = (const float*)d_in[i];
    p.out = (float*)d_out; p.ws = (unsigned char*)d_ws;
    for (int i = 0; i < 16; ++i) p.inv_freq[i] = (float)pow(500000.0, -(double)(2 * i) / 32.0);
    void* args[] = {&p};
    hipError_t e = hipLaunchCooperativeKernel((const void*)mega_fwd, dim3(grid), dim3(NWAVES * 64), args, LDS_BYTES, stream);
    if (e != hipSuccess) fprintf(stderr, "cooperative launch failed: %s (grid %d)\n", hipGetErrorString(e), grid);
}
```

```cpp
#include <hip/hip_runtime.h>
#include <hip/hip_cooperative_groups.h>
#include <cstdio>
#include <cstdint>
#include <cmath>
namespace cg = cooperative_groups;
namespace pg8 {
#define PG8_LAS __attribute__((address_space(3)))
typedef unsigned short bf16_t;
typedef short bf16x8 __attribute__((ext_vector_type(8)));
typedef float f32x4 __attribute__((ext_vector_type(4)));
typedef unsigned u32x4 __attribute__((ext_vector_type(4)));
constexpr int BM = 256, BK = 64, HALF = 128, HTB = HALF * BK * 2  , STAGE_BYTES = 8 * HTB, NXCD = 8, WGM = 8;

__host__ __device__ __forceinline__ int lds_byte(int r, int c) { const int st = (r >> 4) * 2 + (c >> 5), rr = r & 15, cc = c & 31, ob = rr * 64 + cc * 2; return st * 1024 + (ob ^ (((ob >> 9) & 1) << 5)); }
__host__ __device__ __forceinline__ void stage_rc(int b, int& R, int& C) { const int st = b / 1024, sb = b % 1024, swz = sb ^ (((sb >> 9) & 1) << 5); R = (st >> 1) * 16 + swz / 64; C = (st & 1) * 32 + (swz % 64) / 2; }
__host__ __device__ __forceinline__ int perm32(int rho) { const int n = rho >> 4, i = rho & 15; return 8 * (i >> 2) + 4 * n + (i & 3); }

struct Unit { int pm, pn; };
struct Gemm { const bf16_t* A; const bf16_t* Bt; int M, N, K; };

struct StaticOrder {
    int nM, nN, nwg, G, c;
    __host__ __device__ void init(int M, int N, int G_, int c_) { nM = M / BM; nN = N / BM; nwg = nM * nN; G = G_; c = c_; }
    __host__ __device__ bool next(int i, Unit& u) const {
        const long L = (long)i * G + c; if (L >= nwg) return false;
        int wgid = (int)L; { const int q = nwg / NXCD, r = nwg % NXCD, xcd = wgid % NXCD, off = wgid / NXCD; wgid = (xcd < r ? xcd * (q + 1) : r * (q + 1) + (xcd - r) * q) + off; }
        const int nig = WGM * nN, gid = wgid / nig, fm = gid * WGM, gsz = (nM - fm) < WGM ? (nM - fm) : WGM;
        u.pm = fm + ((wgid % nig) % gsz); u.pn = (wgid % nig) / gsz; return true;
    }
    __device__ __forceinline__ void a_ready(const Unit&) const {}
    __device__ __forceinline__ void done(const Unit&) const {}
};
typedef __bf16 bf16x2_t __attribute__((ext_vector_type(2)));
__device__ __forceinline__ unsigned cvt_pk_bf16(float lo, float hi) { const float __attribute__((ext_vector_type(2))) v = {lo, hi}; return __builtin_bit_cast(unsigned, __builtin_convertvector(v, bf16x2_t)); }
typedef float f32x2 __attribute__((ext_vector_type(2)));
__device__ __forceinline__ f32x2 gelu_pk(f32x2 v) {
    const f32x2 av = __builtin_elementwise_abs(v), d = av * 0.2316418882f + 1.0f;
    f32x2 t; t.x = __builtin_amdgcn_rcpf(d.x); t.y = __builtin_amdgcn_rcpf(d.y);
    f32x2 q = t * 0.5307027145f + (-0.7265760135f); q = q * t + 0.7107068705f; q = q * t + (-0.142248368f); q = q * t + 0.127414796f; q = q * t;
    const f32x2 s = (v * v) * (-0.72134752044f);
    f32x2 e; e.x = __builtin_amdgcn_exp2f(s.x); e.y = __builtin_amdgcn_exp2f(s.y);
    const f32x2 m = v * (q * e), r = v - m;
    f32x2 o; o.x = v.x < 0.f ? m.x : r.x; o.y = v.y < 0.f ? m.y : r.y; return o;
}
template <class Epi, class Sched, bool ALIGN_EPI = false, bool SP2 = false>
__device__ __forceinline__ void gemm_phase(PG8_LAS unsigned char* lds, const Gemm g, const Sched& S, const Epi& E) {
    int tid_ = threadIdx.x; asm volatile("" : "+v"(tid_));
    const int tid = tid_, wid = __builtin_amdgcn_readfirstlane(tid >> 6), lane = tid & 63, wr = wid >> 2, wc = wid & 3, fr = lane & 15, fq = lane >> 4;
    const int K = g.K, nt = K / BK;
    unsigned voffA[2], voffB[2];
#pragma unroll
    for (int i = 0; i < 2; ++i) { int R, C; stage_rc(tid * 16 + i * 8192, R, C); const int Rb = Epi::PERM ? ((R & ~31) + perm32(R & 31)) : R;
        voffA[i] = (unsigned)(R * K + C) * 2u; voffB[i] = (unsigned)(Rb * K + C) * 2u; }
    const size_t kstep = (size_t)(BK * 2);
    const size_t hstep = (size_t)HALF * K * 2;
    const size_t tstep = 2 * hstep;
    const unsigned ldsw = (unsigned)wid * 1024u;
    const int aoff = lds_byte(wr * 64 + fr, fq * 8), boff = lds_byte(wc * 32 + fr, fq * 8);
#define PG8_SA(b, h) (((b) * 2 + (h)) * HTB)
#define PG8_SB(b, h) ((4 + (b) * 2 + (h)) * HTB)
#define PG8_STAGE(bufoff, gbase, voff) do { _Pragma("unroll") for (int _i = 0; _i < 2; ++_i) \
        __builtin_amdgcn_global_load_lds((const unsigned*)((const char*)(gbase) + (voff)[_i]), (PG8_LAS unsigned*)(lds + (bufoff) + ldsw + _i * 8192), 16, 0, 0); } while (0)
#define PG8_LDA(dst, b, h) do { _Pragma("unroll") for (int m = 0; m < 4; ++m) _Pragma("unroll") for (int k = 0; k < 2; ++k) dst[m][k] = *(const PG8_LAS bf16x8*)(lds + PG8_SA(b, h) + aoff + m * 2048 + k * 1024); } while (0)
#define PG8_LDB(dst, b, h) do { _Pragma("unroll") for (int n = 0; n < 2; ++n) _Pragma("unroll") for (int k = 0; k < 2; ++k) dst[n][k] = *(const PG8_LAS bf16x8*)(lds + PG8_SB(b, h) + boff + n * 2048 + k * 1024); } while (0)
#define PG8_MMA(ai, bj, At, Bt) do { __builtin_amdgcn_s_setprio(1); _Pragma("unroll") for (int m = 0; m < 4; ++m) _Pragma("unroll") for (int n = 0; n < 2; ++n) _Pragma("unroll") for (int k = 0; k < 2; ++k) \
        acc[ai][bj][m][n] = __builtin_amdgcn_mfma_f32_16x16x32_bf16(Bt[n][k], At[m][k], acc[ai][bj][m][n], 0, 0, 0); __builtin_amdgcn_s_setprio(0); } while (0)
#define PG8_WAIT_V(n) asm volatile("s_waitcnt vmcnt(" #n ")" ::: "memory")
#define PG8_WAIT_L(n) asm volatile("s_waitcnt lgkmcnt(" #n ")" ::: "memory")
#define PG8_BAR __builtin_amdgcn_s_barrier()
#define PG8_SCHED __builtin_amdgcn_sched_barrier(0)
    Unit cur, nxt; int ui = 0;
    if (!S.next(0, cur)) return;
    f32x4 acc[2][2][4][2];
#pragma unroll
    for (int a = 0; a < 2; ++a)
#pragma unroll
        for (int b = 0; b < 2; ++b)
#pragma unroll
            for (int m = 0; m < 4; ++m)
#pragma unroll
                for (int n = 0; n < 2; ++n) acc[a][b][m][n] = (f32x4){0.f, 0.f, 0.f, 0.f};
    bf16x8 At[4][2], B0[2][2], B1[2][2];
    const char* cA = (const char*)g.A + (size_t)cur.pm * tstep; const char* cB = (const char*)g.Bt + (size_t)cur.pn * tstep;
    S.a_ready(cur);
    if constexpr (SP2) {
        PG8_STAGE(PG8_SB(0, 0), cB, voffB); PG8_STAGE(PG8_SB(0, 1), cB + hstep, voffB); PG8_STAGE(PG8_SA(0, 0), cA, voffA); PG8_STAGE(PG8_SA(0, 1), cA + hstep, voffA);
        if (wr == 1) PG8_BAR;
        PG8_WAIT_V(2); PG8_BAR;
        PG8_STAGE(PG8_SB(1, 0), cB + kstep, voffB); PG8_STAGE(PG8_SA(1, 0), cA + kstep, voffA); PG8_STAGE(PG8_SB(1, 1), cB + hstep + kstep, voffB);
        PG8_WAIT_V(6); PG8_BAR;
    } else {
        PG8_STAGE(PG8_SB(0, 0), cB, voffB); PG8_STAGE(PG8_SA(0, 0), cA, voffA); PG8_STAGE(PG8_SB(0, 1), cB + hstep, voffB); PG8_STAGE(PG8_SA(0, 1), cA + hstep, voffA);
        if (wr == 1) PG8_BAR;
        PG8_WAIT_V(4); PG8_BAR;
        PG8_STAGE(PG8_SB(1, 0), cB + kstep, voffB); PG8_STAGE(PG8_SA(1, 0), cA + kstep, voffA); PG8_STAGE(PG8_SB(1, 1), cB + hstep + kstep, voffB);
        PG8_WAIT_V(6); PG8_BAR;
    }
    for (;;) {
        const bool has_next = S.next(ui + 1, nxt);
        const char* nA = has_next ? (const char*)g.A + (size_t)nxt.pm * tstep : cA; const char* nB = has_next ? (const char*)g.Bt + (size_t)nxt.pn * tstep : cB;
        for (int t = 0; t < nt; t += 2) {
            const bool last = (t == nt - 2);
            const char* a1 = cA + (size_t)(t + 1) * kstep;
            const char* a2 = last ? nA : cA + (size_t)(t + 2) * kstep; const char* b2 = last ? nB : cB + (size_t)(t + 2) * kstep;
            const char* a3 = a2 + kstep; const char* b3 = b2 + kstep;
            if (last && has_next) S.a_ready(nxt);
            if constexpr (SP2) {
            PG8_LDB(B0, 0, 0); PG8_LDB(B1, 0, 1); PG8_SCHED; PG8_LDA(At, 0, 0); PG8_STAGE(PG8_SA(1, 1), a1 + hstep, voffA);
            PG8_WAIT_V(8); PG8_WAIT_L(0); PG8_BAR; PG8_MMA(0, 0, At, B0); PG8_MMA(0, 1, At, B1); PG8_BAR; PG8_SCHED;
            PG8_LDA(At, 0, 1); PG8_STAGE(PG8_SB(0, 0), b2, voffB); PG8_STAGE(PG8_SB(0, 1), b2 + hstep, voffB); PG8_STAGE(PG8_SA(0, 0), a2, voffA);
            PG8_WAIT_V(8); PG8_WAIT_L(0); PG8_BAR; PG8_MMA(1, 0, At, B0); PG8_MMA(1, 1, At, B1); PG8_BAR; PG8_SCHED;
            PG8_LDB(B0, 1, 0); PG8_LDB(B1, 1, 1); PG8_SCHED; PG8_LDA(At, 1, 0); PG8_STAGE(PG8_SA(0, 1), a2 + hstep, voffA);
            PG8_WAIT_V(8); PG8_WAIT_L(0); PG8_BAR; PG8_MMA(0, 0, At, B0); PG8_MMA(0, 1, At, B1); PG8_BAR; PG8_SCHED;
            PG8_LDA(At, 1, 1); PG8_STAGE(PG8_SB(1, 0), b3, voffB); PG8_STAGE(PG8_SB(1, 1), b3 + hstep, voffB); PG8_STAGE(PG8_SA(1, 0), a3, voffA);
            PG8_WAIT_V(8); PG8_WAIT_L(0); PG8_BAR; PG8_MMA(1, 0, At, B0); PG8_MMA(1, 1, At, B1); PG8_BAR; PG8_SCHED;
            } else {
            PG8_LDB(B0, 0, 0); PG8_SCHED; PG8_LDA(At, 0, 0); PG8_STAGE(PG8_SA(1, 1), a1 + hstep, voffA);
            PG8_WAIT_L(8); PG8_BAR; PG8_WAIT_L(0); PG8_MMA(0, 0, At, B0); PG8_BAR; PG8_SCHED;
            PG8_LDB(B1, 0, 1); PG8_STAGE(PG8_SB(0, 0), b2, voffB);
            PG8_BAR; PG8_WAIT_L(0); PG8_MMA(0, 1, At, B1); PG8_BAR;
            PG8_LDA(At, 0, 1); PG8_STAGE(PG8_SA(0, 0), a2, voffA);
            PG8_BAR; PG8_WAIT_L(0); PG8_MMA(1, 0, At, B0); PG8_BAR; PG8_SCHED;
            PG8_STAGE(PG8_SB(0, 1), b2 + hstep, voffB);
            PG8_WAIT_V(6); PG8_BAR; PG8_MMA(1, 1, At, B1); PG8_BAR;
            PG8_LDB(B0, 1, 0); PG8_SCHED; PG8_LDA(At, 1, 0); PG8_STAGE(PG8_SA(0, 1), a2 + hstep, voffA);
            PG8_WAIT_L(8); PG8_BAR; PG8_WAIT_L(0); PG8_MMA(0, 0, At, B0); PG8_BAR; PG8_SCHED;
            PG8_LDB(B1, 1, 1); PG8_STAGE(PG8_SB(1, 0), b3, voffB);
            PG8_BAR; PG8_WAIT_L(0); PG8_MMA(0, 1, At, B1); PG8_BAR;
            PG8_LDA(At, 1, 1); PG8_STAGE(PG8_SA(1, 0), a3, voffA);
            PG8_BAR; PG8_WAIT_L(0); PG8_MMA(1, 0, At, B0); PG8_BAR; PG8_SCHED;
            PG8_STAGE(PG8_SB(1, 1), b3 + hstep, voffB);
            PG8_WAIT_V(6); PG8_BAR; PG8_MMA(1, 1, At, B1); PG8_BAR;
            }
        }
        if constexpr (ALIGN_EPI) { if (wr == 0) PG8_BAR; }
        if constexpr (!Epi::AFTER_DRAIN) { E(acc, cur, wr, wc, fr, fq); S.done(cur); }
        if (!has_next) break;
#pragma unroll
        for (int a = 0; a < 2; ++a)
#pragma unroll
            for (int b = 0; b < 2; ++b)
#pragma unroll
                for (int m = 0; m < 4; ++m)
#pragma unroll
                    for (int n = 0; n < 2; ++n) acc[a][b][m][n] = (f32x4){0.f, 0.f, 0.f, 0.f};
        cur = nxt; cA = nA; cB = nB; ++ui;
        if constexpr (ALIGN_EPI) { if (wr == 1) PG8_BAR; }
    }
    PG8_WAIT_V(0);
    if constexpr (!ALIGN_EPI) { if (wr == 0) PG8_BAR; }
    PG8_BAR;
    if constexpr (Epi::AFTER_DRAIN) { E.fused(acc, cur, wr, wc, fr, fq, lds, wid, lane); S.done(cur); }
#undef PG8_SA
#undef PG8_SB
#undef PG8_STAGE
#undef PG8_LDA
#undef PG8_LDB
#undef PG8_MMA
#undef PG8_WAIT_V
#undef PG8_WAIT_L
#undef PG8_BAR
#undef PG8_SCHED
}
}

constexpr int T = 16384, SEQ = 4096, DM = 2048, DFF = 5632, AW = 1536, NIN = 11776, NWAVES = 8;
constexpr int LDS_BYTES = 147456;

#define LAS __attribute__((address_space(3)))
typedef unsigned short bf16;
typedef float f32x4 __attribute__((ext_vector_type(4)));
typedef float f32x2 __attribute__((ext_vector_type(2)));
typedef unsigned u32x4 __attribute__((ext_vector_type(4)));
typedef unsigned u32x2 __attribute__((ext_vector_type(2)));
typedef short bf16x8 __attribute__((ext_vector_type(8)));
typedef short s16x4 __attribute__((ext_vector_type(4)));

constexpr size_t SZ_TA = (size_t)T * AW * 2;
constexpr size_t SZ_TD = (size_t)T * DM * 2;
constexpr size_t OFF_WIN = 0;
constexpr size_t OFF_WAO = OFF_WIN + (size_t)NIN * DM * 2;
constexpr size_t OFF_WSO = OFF_WAO + (size_t)DM * 512 * 2;
constexpr size_t OFF_WO  = OFF_WSO + (size_t)DM * AW * 2;
constexpr size_t OFF_H   = OFF_WO + (size_t)DM * DM * 2;
constexpr size_t OFF_STATS = OFF_H + SZ_TD;
constexpr size_t OFF_ML  = OFF_STATS + (size_t)T * 24 * 8;
constexpr size_t OFF_ROPE = OFF_ML + (size_t)3 * T * 4 * 8;
constexpr size_t OFF_SSQ = OFF_ROPE + (size_t)SEQ * 16 * 2 * 4;
constexpr size_t OFF_Z   = OFF_SSQ + (size_t)T * 32 * 4;
constexpr size_t ZGA = 0, ZGS = SZ_TD, ZQ = 2 * SZ_TD, ZK = ZQ + SZ_TA, ZV = ZQ + 2 * SZ_TA, ZGV = ZQ + 3 * SZ_TA, ZU = ZQ + 4 * SZ_TA, ZEND = ZQ + 5 * SZ_TA;
constexpr size_t ZACT = 0, ZTMP = ZQ, ZMRG = ZQ + SZ_TD, ZWGU = ZGV, ZWD = ZWGU + (size_t)2 * DFF * DM * 2;
constexpr size_t OFF_CTL = OFF_Z + ZEND;
constexpr size_t WS_NEED = OFF_CTL + 4096;
static_assert((size_t)T * DFF * 2 <= ZWGU && ZWD + (size_t)DM * DFF * 2 <= ZEND && ZMRG + SZ_TD <= ZWGU, "ws overlay map");

struct Params {
    const float* in[19];
    float* out;
    unsigned char* ws;
    float inv_freq[16];
};

__device__ __forceinline__ unsigned pk2(float lo, float hi) { return pg8::cvt_pk_bf16(lo, hi); }
__device__ __forceinline__ float bflo(unsigned w) { return __uint_as_float(w << 16); }
__device__ __forceinline__ float bfhi(unsigned w) { return __uint_as_float(w & 0xffff0000u); }
__device__ __forceinline__ float wave_sum(float v) {
#pragma unroll
    for (int o = 1; o < 64; o <<= 1) v += __shfl_xor(v, o);
    return v;
}
__device__ __forceinline__ float fast_sigmoid(float x) { return __builtin_amdgcn_rcpf(1.0f + __builtin_amdgcn_exp2f(-1.4426950408889634f * x)); }
__device__ __forceinline__ f32x4 gelu4(f32x4 v) {
    const f32x2 a = pg8::gelu_pk((f32x2){v[0], v[1]}), b = pg8::gelu_pk((f32x2){v[2], v[3]});
    return (f32x4){a.x, a.y, b.x, b.y};
}
__device__ __forceinline__ u32x4 pack8(f32x4 v0, f32x4 v1) { u32x4 w; w.x = pk2(v0[0], v0[1]); w.y = pk2(v0[2], v0[3]); w.z = pk2(v1[0], v1[1]); w.w = pk2(v1[2], v1[3]); return w; }

typedef pg8::Unit Unit;
struct EpiSwiGLU {
    static constexpr bool PERM = true, AFTER_DRAIN = false;
    bf16* O; const LAS float* rt;
    __device__ __forceinline__ void operator()(const f32x4 (&acc)[2][2][4][2], const Unit& u, int wr, int wc, int fr, int fq) const {
        const int row0 = u.pm * 256 + wr * 64 + fr, col0 = u.pn * 128 + wc * 32 + 8 * fq;
#pragma unroll
        for (int ai = 0; ai < 2; ++ai)
#pragma unroll
            for (int m = 0; m < 4; ++m) {
                bf16* rowp = O + (size_t)(row0 + ai * 128 + m * 16) * DFF + col0;
                const float rr = rt[ai * 128 + wr * 64 + m * 16 + fr];
                f32x4 a, b;
#pragma unroll
                for (int j = 0; j < 4; ++j) {
                    const float g0 = acc[ai][0][m][0][j] * rr, g1 = acc[ai][0][m][1][j] * rr;
                    a[j] = g0 * fast_sigmoid(g0) * (acc[ai][1][m][0][j] * rr);
                    b[j] = g1 * fast_sigmoid(g1) * (acc[ai][1][m][1][j] * rr);
                }
                *(u32x4*)rowp = pack8(a, b);
            }
    }
};
struct EpiResid {
    static constexpr bool PERM = false, AFTER_DRAIN = false;
    const float* R; float* O; float scale;
    __device__ __forceinline__ void operator()(const f32x4 (&acc)[2][2][4][2], const Unit& u, int wr, int wc, int fr, int fq) const {
        const int row0 = u.pm * 256 + wr * 64 + fr, col0 = u.pn * 256 + wc * 32 + 4 * fq;
#pragma unroll
        for (int ai = 0; ai < 2; ++ai)
#pragma unroll
            for (int m = 0; m < 4; ++m) {
                const size_t off = (size_t)(row0 + ai * 128 + m * 16) * DM + col0;
#pragma unroll
                for (int bj = 0; bj < 2; ++bj)
#pragma unroll
                    for (int n = 0; n < 2; ++n) {
                        const f32x4 r = *(const f32x4*)(R + off + bj * 128 + n * 16);
                        *(f32x4*)(O + off + bj * 128 + n * 16) = r + scale * acc[ai][bj][m][n];
                    }
            }
    }
};
struct EpiResidN {
    static constexpr bool PERM = false, AFTER_DRAIN = false;
    const float* R; float* O; float scale; const float* gn; bf16* A2; float* ssq;
    __device__ __forceinline__ void operator()(const f32x4 (&acc)[2][2][4][2], const Unit& u, int wr, int wc, int fr, int fq) const {
        const int row0 = u.pm * 256 + wr * 64 + fr, col0 = u.pn * 256 + wc * 32 + 4 * fq;
        f32x4 gv[2][2];
#pragma unroll
        for (int bj = 0; bj < 2; ++bj)
#pragma unroll
            for (int n = 0; n < 2; ++n) gv[bj][n] = *(const f32x4*)(gn + col0 + bj * 128 + n * 16);
#pragma unroll
        for (int ai = 0; ai < 2; ++ai)
#pragma unroll
            for (int m = 0; m < 4; ++m) {
                const int row = row0 + ai * 128 + m * 16;
                const size_t off = (size_t)row * DM + col0;
                float s = 0.f;
#pragma unroll
                for (int bj = 0; bj < 2; ++bj)
#pragma unroll
                    for (int n = 0; n < 2; ++n) {
                        const f32x4 r = *(const f32x4*)(R + off + bj * 128 + n * 16);
                        const f32x4 o = r + scale * acc[ai][bj][m][n];
                        *(f32x4*)(O + off + bj * 128 + n * 16) = o;
                        s += (o[0] * o[0] + o[1] * o[1]) + (o[2] * o[2] + o[3] * o[3]);
                        const f32x4 w = o * gv[bj][n];
                        u32x2 pw; pw.x = pk2(w[0], w[1]); pw.y = pk2(w[2], w[3]);
                        *(u32x2*)(A2 + off + bj * 128 + n * 16) = pw;
                    }
                s += __shfl_xor(s, 16); s += __shfl_xor(s, 32);
                if (fq == 0) ssq[(size_t)row * 32 + u.pn * 4 + wc] = s;
            }
    }
};
struct EpiWin {
    static constexpr bool PERM = true, AFTER_DRAIN = false;
    bf16 *Q, *Kb, *V, *U, *GV, *GA, *GS; f32x2* stats; const float *cosT, *sinT; const LAS float* rt;
    __device__ __forceinline__ void operator()(const f32x4 (&acc)[2][2][4][2], const Unit& u, int wr, int wc, int fr, int fq) const {
        const int pn = (NIN / 256 - 1) - u.pn, row0 = u.pm * 256 + wr * 64 + fr, cw = wc * 32 + 8 * fq;
        if (pn < 18) {
            bf16* base = Q + (size_t)(pn / 6) * ((size_t)T * AW);
            const int colt = (pn % 6) * 256 + cw;
            const bool rope = (pn < 12) && (wc == 0);
            const float sgn = fq < 2 ? -1.f : 1.f;
#pragma unroll
            for (int ai = 0; ai < 2; ++ai)
#pragma unroll
                for (int m = 0; m < 4; ++m) {
                    const int row = row0 + ai * 128 + m * 16, pos = row & (SEQ - 1);
                    const float rr = rt[ai * 128 + wr * 64 + m * 16 + fr];
#pragma unroll
                    for (int bj = 0; bj < 2; ++bj) {
                        f32x4 v0 = acc[ai][bj][m][0] * rr, v1 = acc[ai][bj][m][1] * rr;
                        if (rope) {
                            f32x4 p0, p1;
#pragma unroll
                            for (int j = 0; j < 4; ++j) { p0[j] = __shfl_xor(v0[j], 32); p1[j] = __shfl_xor(v1[j], 32); }
                            const int i0 = pos * 16 + 8 * (fq & 1);
                            const f32x4 c0 = *(const f32x4*)(cosT + i0), c1 = *(const f32x4*)(cosT + i0 + 4);
                            const f32x4 s0 = *(const f32x4*)(sinT + i0), s1 = *(const f32x4*)(sinT + i0 + 4);
                            v0 = v0 * c0 + sgn * (p0 * s0); v1 = v1 * c1 + sgn * (p1 * s1);
                        }
                        *(u32x4*)(base + (size_t)row * AW + colt + bj * 128) = pack8(v0, v1);
                    }
                }
        } else if (pn < 24) {
            const int colt = (pn - 18) * 256 + cw;
#pragma unroll
            for (int ai = 0; ai < 2; ++ai)
#pragma unroll
                for (int m = 0; m < 4; ++m) {
                    const int row = row0 + ai * 128 + m * 16;
                    const float rr = rt[ai * 128 + wr * 64 + m * 16 + fr];
#pragma unroll
                    for (int bj = 0; bj < 2; ++bj)
                        *(u32x4*)(U + (size_t)row * AW + colt + bj * 128) = pack8(gelu4(acc[ai][bj][m][0] * rr), gelu4(acc[ai][bj][m][1] * rr));
                }
        } else if (pn < 30) {
            const int colt = (pn - 24) * 256 + cw;
#pragma unroll
            for (int ai = 0; ai < 2; ++ai)
#pragma unroll
                for (int m = 0; m < 4; ++m) {
                    const int row = row0 + ai * 128 + m * 16;
                    float s = 0.f, ss = 0.f;
                    const float rr = rt[ai * 128 + wr * 64 + m * 16 + fr];
#pragma unroll
                    for (int bj = 0; bj < 2; ++bj) {
                        const f32x4 a = gelu4(acc[ai][bj][m][0] * rr), b = gelu4(acc[ai][bj][m][1] * rr);
                        s += (a[0] + a[1]) + (a[2] + a[3]) + (b[0] + b[1]) + (b[2] + b[3]);
                        ss += (a[0] * a[0] + a[1] * a[1]) + (a[2] * a[2] + a[3] * a[3]) + (b[0] * b[0] + b[1] * b[1]) + (b[2] * b[2] + b[3] * b[3]);
                        *(u32x4*)(GV + (size_t)row * AW + colt + bj * 128) = pack8(a, b);
                    }
                    s += __shfl_xor(s, 16); s += __shfl_xor(s, 32);
                    ss += __shfl_xor(ss, 16); ss += __shfl_xor(ss, 32);
                    if (fq == 0) stats[(size_t)row * 24 + (pn - 24) * 4 + wc] = (f32x2){s, ss};
                }
        } else {
            bf16* base = GA + (size_t)(pn < 38 ? 0 : 1) * ((size_t)T * DM);
            const int colt = (pn < 38 ? pn - 30 : pn - 38) * 256 + cw;
#pragma unroll
            for (int ai = 0; ai < 2; ++ai)
#pragma unroll
                for (int m = 0; m < 4; ++m) {
                    const int row = row0 + ai * 128 + m * 16;
                    const float rr = rt[ai * 128 + wr * 64 + m * 16 + fr];
#pragma unroll
                    for (int bj = 0; bj < 2; ++bj) {
                        f32x4 a = acc[ai][bj][m][0] * rr, b = acc[ai][bj][m][1] * rr;
#pragma unroll
                        for (int j = 0; j < 4; ++j) { a[j] = fast_sigmoid(a[j]); b[j] = fast_sigmoid(b[j]); }
                        *(u32x4*)(base + (size_t)row * DM + colt + bj * 128) = pack8(a, b);
                    }
                }
        }
    }
};
template <int MODE> struct EpiGate {
    static constexpr bool PERM = true, AFTER_DRAIN = false;
    const bf16* G; const bf16* P; bf16* O;
    __device__ __forceinline__ void operator()(const f32x4 (&acc)[2][2][4][2], const Unit& u, int wr, int wc, int fr, int fq) const {
        const int row0 = u.pm * 256 + wr * 64 + fr, col0 = u.pn * 256 + wc * 32 + 8 * fq;
#pragma unroll
        for (int ai = 0; ai < 2; ++ai)
#pragma unroll
            for (int m = 0; m < 4; ++m) {
                const size_t off = (size_t)(row0 + ai * 128 + m * 16) * DM + col0;
#pragma unroll
                for (int bj = 0; bj < 2; ++bj) {
                    const u32x4 g = *(const u32x4*)(G + off + bj * 128);
                    f32x4 a = acc[ai][bj][m][0], b = acc[ai][bj][m][1];
                    a[0] *= bflo(g.x); a[1] *= bfhi(g.x); a[2] *= bflo(g.y); a[3] *= bfhi(g.y);
                    b[0] *= bflo(g.z); b[1] *= bfhi(g.z); b[2] *= bflo(g.w); b[3] *= bfhi(g.w);
                    if (MODE == 1) {
                        const u32x4 t = *(const u32x4*)(P + off + bj * 128);
                        a[0] += bflo(t.x); a[1] += bfhi(t.x); a[2] += bflo(t.y); a[3] += bfhi(t.y);
                        b[0] += bflo(t.z); b[1] += bfhi(t.z); b[2] += bflo(t.w); b[3] += bfhi(t.w);
                    }
                    *(u32x4*)(O + off + bj * 128) = pack8(a, b);
                }
            }
    }
};

__device__ __forceinline__ float q6(float f) { unsigned u = __float_as_uint(f); u += 0xFFFFu + ((u >> 17) & 1u); u &= 0xFFFE0000u; return __uint_as_float(u); }
constexpr int TR_SCR = 64 * 65 * 4;
__device__ __forceinline__ void transpose_item(const float* W, int K, int N, bf16* WT, int k0, int n0, int drow0, LAS float* scr, int lane) {
    const int cq = lane & 15, rq = lane >> 4;
    f32x4 v[16];
#pragma unroll
    for (int i = 0; i < 16; ++i) v[i] = __builtin_nontemporal_load((const f32x4*)(W + (size_t)(k0 + 4 * i + rq) * N + n0 + 4 * cq));
#pragma unroll
    for (int i = 0; i < 16; ++i) { LAS float* d = scr + (4 * i + rq) * 65 + 4 * cq; d[0] = v[i][0]; d[1] = v[i][1]; d[2] = v[i][2]; d[3] = v[i][3]; }
    asm volatile("s_waitcnt lgkmcnt(0)" ::: "memory");
    const int c = lane & 7;
#pragma unroll
    for (int j = 0; j < 8; ++j) { const int n = (lane >> 3) + 8 * j; const LAS float* s = scr + (8 * c) * 65 + n;
        u32x4 o; o.x = pk2(q6(s[0 * 65]), q6(s[1 * 65])); o.y = pk2(q6(s[2 * 65]), q6(s[3 * 65])); o.z = pk2(q6(s[4 * 65]), q6(s[5 * 65])); o.w = pk2(q6(s[6 * 65]), q6(s[7 * 65]));
        *(u32x4*)(WT + (size_t)(drow0 + n) * K + k0 + 8 * c) = o; }
    asm volatile("s_waitcnt lgkmcnt(0)" ::: "memory");
}
__device__ __forceinline__ bool transpose_seg(int& it, const float* W, int K, int N, bf16* WT, int map, LAS float* scr, int lane) {
    const int nblk = N / 64, nitems = (K / 64) * nblk;
    if (it >= nitems) { it -= nitems; return false; }
    const int kb = it / nblk, nb = it % nblk, n0 = nb * 64;
    const int drow0 = map == 0 ? n0 : (map == 3 ? ((N / 256 - 1 - (n0 >> 8)) * 256 + (n0 & 255)) : ((n0 >> 7) * 256 + (n0 & 127) + (map == 2 ? 128 : 0)));
    transpose_item(W, K, N, WT, kb * 64, n0, drow0, scr, lane);
    return true;
}
__device__ __forceinline__ void rms_row_bf16(const float* xrow, const float* g, bf16* orow, int lane) {
    f32x4 v[8]; float s = 0.f;
#pragma unroll
    for (int j = 0; j < 8; ++j) { v[j] = __builtin_nontemporal_load((const f32x4*)xrow + j * 64 + lane);
        s += (v[j][0] * v[j][0] + v[j][1] * v[j][1]) + (v[j][2] * v[j][2] + v[j][3] * v[j][3]); }
    const float r = 1.0f / sqrtf(wave_sum(s) * (1.0f / DM) + 1e-6f);
#pragma unroll
    for (int j = 0; j < 8; ++j) { const f32x4 gg = ((const f32x4*)g)[j * 64 + lane]; const f32x4 o = v[j] * r * gg;
        u32x2 w; w.x = pk2(o[0], o[1]); w.y = pk2(o[2], o[3]); ((u32x2*)orow)[j * 64 + lane] = w; }
}
__device__ __forceinline__ void rms_row_f32(const float* xrow, const float* g, float* orow, int lane) {
    f32x4 v[8]; float s = 0.f;
#pragma unroll
    for (int j = 0; j < 8; ++j) { v[j] = ((const f32x4*)xrow)[j * 64 + lane]; s += (v[j][0] * v[j][0] + v[j][1] * v[j][1]) + (v[j][2] * v[j][2] + v[j][3] * v[j][3]); }
    const float r = 1.0f / sqrtf(wave_sum(s) * (1.0f / DM) + 1e-6f);
#pragma unroll
    for (int j = 0; j < 8; ++j) { const f32x4 gg = ((const f32x4*)g)[j * 64 + lane]; ((f32x4*)orow)[j * 64 + lane] = v[j] * r * gg; }
}
__device__ __forceinline__ void sincos_tab(double a, float& s, float& c) {
    const double kq = rint(a * 0.63661977236758134308);
    double rd = fma(-kq, 1.57079632679489655800, a); rd = fma(-kq, 6.12323399573676603587e-17, rd);
    const int q = ((int)kq) & 3;
    const float r = (float)rd, r2 = r * r;
    const float sp = r * (1.0f + r2 * (-1.0f / 6.0f + r2 * (1.0f / 120.0f + r2 * (-1.0f / 5040.0f + r2 * (1.0f / 362880.0f + r2 * (-1.0f / 39916800.0f))))));
    const float cp = 1.0f + r2 * (-0.5f + r2 * (1.0f / 24.0f + r2 * (-1.0f / 720.0f + r2 * (1.0f / 40320.0f + r2 * (-1.0f / 3628800.0f + r2 * (1.0f / 479001600.0f))))));
    s = (q == 0) ? sp : (q == 1) ? cp : (q == 2) ? -sp : -cp;
    c = (q == 0) ? cp : (q == 1) ? -sp : (q == 2) ? -cp : sp;
}

constexpr int KV_STRIDE = 272;
constexpr int ATT_V_OFF = 256 * KV_STRIDE;
__device__ __forceinline__ bf16x8 tr_pair(LAS unsigned char* p0, LAS unsigned char* p1) {
    const s16x4 a = __builtin_amdgcn_ds_read_tr16_b64_v4i16((LAS s16x4*)p0);
    const s16x4 b = __builtin_amdgcn_ds_read_tr16_b64_v4i16((LAS s16x4*)p1);
    return (bf16x8){a[0], a[1], a[2], a[3], b[0], b[1], b[2], b[3]};
}
struct AttnIdx { int grp, b, hh, r, n, dsh, colbase; };
__device__ __forceinline__ AttnIdx attn_decode(int item) {
    AttnIdx a; a.grp = item >> 9; a.b = (item >> 7) & 3; a.hh = (item >> 5) & 3; const int rb = item & 31;
    a.dsh = 2 * a.grp; const int nbsh = 5 - 2 * a.grp; a.r = rb >> nbsh; a.n = rb & ((1 << nbsh) - 1); a.colbase = (a.grp * 4 + a.hh) * 128; return a;
}
__device__ __forceinline__ void attn_fetch_block(const bf16* Kb, const bf16* Vb, const AttnIdx& a, int nb, int tid, u32x4 (&kv)[4], u32x4 (&vv)[4]) {
    const int c = tid & 15, r0 = tid >> 4;
#pragma unroll
    for (int it = 0; it < 4; ++it) {
        const int ri = nb * 128 + it * 32 + r0;
        const size_t row = (size_t)a.b * SEQ + (((size_t)ri << a.dsh) + a.r);
        kv[it] = *(const u32x4*)(Kb + row * AW + a.colbase + c * 8); vv[it] = *(const u32x4*)(Vb + row * AW + a.colbase + c * 8);
    }
}
__device__ __forceinline__ void attn_store_block(LAS unsigned char* lds, int half, int tid, const u32x4 (&kv)[4], const u32x4 (&vv)[4]) {
    const int c = tid & 15, r0 = tid >> 4;
#pragma unroll
    for (int it = 0; it < 4; ++it) {
        const int row = half * 128 + it * 32 + r0;
        *(LAS u32x4*)(lds + row * KV_STRIDE + c * 16) = kv[it]; *(LAS u32x4*)(lds + ATT_V_OFF + row * KV_STRIDE + c * 16) = vv[it];
    }
}
__device__ __forceinline__ void attn_zero_block(LAS unsigned char* lds, int half, int tid) {
    const u32x4 z = {0u, 0u, 0u, 0u}; u32x4 kz[4] = {z, z, z, z};
    attn_store_block(lds, half, tid, kz, kz);
}
__device__ __forceinline__ void attn_fetch_q(const bf16* Qb, const AttnIdx& a, int w, int lane, bf16x8 (&Qf)[4]) {
    const int qi = 16 * w + (lane & 15), g = lane >> 4;
    const size_t rowq = (size_t)a.b * SEQ + ((((size_t)a.n * 128 + qi) << a.dsh) + a.r);
#pragma unroll
    for (int ks = 0; ks < 4; ++ks) Qf[ks] = *(const bf16x8*)(Qb + rowq * AW + a.colbase + 32 * ks + 8 * g);
}
__device__ __forceinline__ void attn_range(const bf16* Qb, const bf16* Kb, const bf16* Vb, bf16* OG, f32x2* ML, LAS unsigned char* lds, int first, int count, int tid) {
    if (count <= 0) return;
    const int w = __builtin_amdgcn_readfirstlane(tid >> 6), lane = tid & 63, l15 = lane & 15, g = lane >> 4;
    LAS unsigned char* Kl = lds; LAS unsigned char* Vl = lds + ATT_V_OFF;
    AttnIdx a = attn_decode(first);
    bf16x8 Qf[4];
    {
        u32x4 kv[4], vv[4];
        if (a.n > 0) { attn_fetch_block(Kb, Vb, a, a.n - 1, tid, kv, vv); attn_store_block(lds, (a.n - 1) & 1, tid, kv, vv); }
        else attn_zero_block(lds, 1, tid);
        attn_fetch_block(Kb, Vb, a, a.n, tid, kv, vv); attn_store_block(lds, a.n & 1, tid, kv, vv);
        attn_fetch_q(Qb, a, w, lane, Qf);
    }
    __syncthreads();
    for (int s = 0; s < count; ++s) {
        const bool has_next = (s + 1 < count);
        AttnIdx an = attn_decode(has_next ? first + s + 1 : first + s);
        u32x4 nkv[4], nvv[4]; bf16x8 nQ[4];
        if (has_next) { attn_fetch_block(Kb, Vb, an, an.n, tid, nkv, nvv); attn_fetch_q(Qb, an, w, lane, nQ); }
        const int n = a.n, hc = n & 1, hp = hc ^ 1;
        const int qi = 16 * w + l15;
        const size_t rowq = (size_t)a.b * SEQ + ((((size_t)n * 128 + qi) << a.dsh) + a.r);
        const int tb = w & ~1;
        f32x4 S[10];
#pragma unroll
        for (int tt = 0; tt < 10; ++tt) {
            S[tt] = (f32x4){0.f, 0.f, 0.f, 0.f};
            const int t = tb + tt, lrow = ((t < 8 ? hp : hc) * 128 + (t & 7) * 16 + l15);
#pragma unroll
            for (int ks = 0; ks < 4; ++ks) {
                const bf16x8 kf = *(const LAS bf16x8*)(Kl + lrow * KV_STRIDE + (32 * ks + 8 * g) * 2);
                S[tt] = __builtin_amdgcn_mfma_f32_16x16x32_bf16(kf, Qf[ks], S[tt], 0, 0, 0);
            }
        }
        const float sc = 0.08838834764831845f * 1.4426950408889634f;
        float mx = -INFINITY;
#pragma unroll
        for (int tt = 0; tt < 10; ++tt)
#pragma unroll
            for (int e = 0; e < 4; ++e) {
                const int kj = 16 * (tb + tt) + 4 * g + e;
                const bool valid = (kj >= qi) && (kj <= qi + 128) && (n > 0 || kj >= 128);
                const float sv = valid ? S[tt][e] * sc : -INFINITY;
                S[tt][e] = sv; mx = fmaxf(mx, sv);
            }
        mx = fmaxf(mx, __shfl_xor(mx, 16)); mx = fmaxf(mx, __shfl_xor(mx, 32));
        float l = 0.f;
#pragma unroll
        for (int tt = 0; tt < 10; ++tt)
#pragma unroll
            for (int e = 0; e < 4; ++e) { const float pv = __builtin_amdgcn_exp2f(S[tt][e] - mx); S[tt][e] = pv; l += pv; }
        l += __shfl_xor(l, 16); l += __shfl_xor(l, 32);
        f32x4 O[8];
#pragma unroll
        for (int dt = 0; dt < 8; ++dt) O[dt] = (f32x4){0.f, 0.f, 0.f, 0.f};
        const int qq = l15 >> 2, pp = lane & 3;
#pragma unroll
        for (int kp = 0; kp < 5; ++kp) {
            const u32x4 pw = pack8(S[2 * kp], S[2 * kp + 1]);
            const bf16x8 pf = __builtin_bit_cast(bf16x8, pw);
            const int t0 = tb + 2 * kp;
            LAS unsigned char* v0 = Vl + ((t0 < 8 ? hp : hc) * 128 + (t0 & 7) * 16 + 4 * g + qq) * KV_STRIDE + 8 * pp;
#pragma unroll
            for (int dt = 0; dt < 8; ++dt) {
                const bf16x8 vf = tr_pair(v0 + 32 * dt, v0 + 16 * KV_STRIDE + 32 * dt);
                O[dt] = __builtin_amdgcn_mfma_f32_16x16x32_bf16(vf, pf, O[dt], 0, 0, 0);
            }
        }
        const float inv = 1.0f / l;
        bf16* op = OG + ((size_t)a.grp * T + rowq) * 512 + a.hh * 128 + 4 * g;
#pragma unroll
        for (int dt = 0; dt < 8; ++dt) { const f32x4 o = O[dt] * inv; u32x2 wv; wv.x = pk2(o[0], o[1]); wv.y = pk2(o[2], o[3]); *(u32x2*)(op + 16 * dt) = wv; }
        if (g == 0) ML[((size_t)a.grp * T + rowq) * 4 + a.hh] = (f32x2){mx, l};
        __syncthreads();
        if (has_next) {
            attn_store_block(lds, an.n & 1, tid, nkv, nvv);
            if (an.n == 0) attn_zero_block(lds, 1, tid);
#pragma unroll
            for (int ks = 0; ks < 4; ++ks) Qf[ks] = nQ[ks];
            a = an;
            __syncthreads();
        }
    }
}

__device__ __forceinline__ void spatial_fetch_stats(const f32x2* stats, size_t t0, int tid, f32x2 (&sv)[24]) {
    if (tid < 128) { const f32x2* sp = stats + (t0 + tid) * 24;
#pragma unroll
        for (int j = 0; j < 24; ++j) sv[j] = sp[j]; }
}
__device__ __forceinline__ void spatial_put_stats(LAS f32x2* st, int tid, const f32x2 (&sv)[24]) {
    if (tid < 128) { float s = 0.f, ss = 0.f;
#pragma unroll
        for (int j = 0; j < 24; ++j) { s += sv[j].x; ss += sv[j].y; }
        const float mean = s * (1.0f / AW), var = fmaxf(ss * (1.0f / AW) - mean * mean, 0.f);
        st[tid] = (f32x2){mean, 1.0f / sqrtf(var + 1e-5f)}; }
}
__device__ __forceinline__ void spatial_fetch_gv(const bf16* GV, size_t t0, int g, int tid, u32x4 (&gv)[4]) {
    const int c = tid & 15, r0 = tid >> 4;
#pragma unroll
    for (int it = 0; it < 4; ++it) gv[it] = *(const u32x4*)(GV + (t0 + it * 32 + r0) * AW + g * 128 + c * 8);
}
__device__ __forceinline__ void spatial_range(const bf16* GV, bf16* U, const f32x2* stats, const float* lng, const float* lnb, const float* sgw, const float* sgb,
                                              LAS unsigned char* lds, int first, int count, int tid) {
    if (count <= 0) return;
    const int w = __builtin_amdgcn_readfirstlane(tid >> 6), lane = tid & 63, l15 = lane & 15, gq = lane >> 4;
    LAS unsigned char* Yl = lds; LAS f32x2* stb = (LAS f32x2*)(lds + 128 * KV_STRIDE);
    const int t = 16 * w + l15, qq = l15 >> 2, pp = lane & 3, c = tid & 15, r0 = tid >> 4;
    int cur_g = -1; bf16x8 Wf[4]; f32x4 g0, g1, b0, b1; float bias = 0.f;
    f32x2 sv[24]; u32x4 gv[4];
    { const int g = first >> 7, ci = first & 127; spatial_fetch_stats(stats, (size_t)ci * 128, tid, sv); spatial_fetch_gv(GV, (size_t)ci * 128, g, tid, gv); spatial_put_stats(stb, tid, sv); }
    for (int s = 0; s < count; ++s) {
        const int item = first + s, g = item >> 7, ci = item & 127;
        const size_t t0 = (size_t)ci * 128;
        LAS f32x2* st = stb + (s & 1) * 128; LAS f32x2* stn = stb + ((s + 1) & 1) * 128;
        if (g != cur_g) {
            cur_g = g;
            g0 = *(const f32x4*)(lng + g * 128 + c * 8); g1 = *(const f32x4*)(lng + g * 128 + c * 8 + 4);
            b0 = *(const f32x4*)(lnb + g * 128 + c * 8); b1 = *(const f32x4*)(lnb + g * 128 + c * 8 + 4);
            bias = sgb[g * 128 + t];
#pragma unroll
            for (int ks = 0; ks < 4; ++ks) {
                const int s0 = 32 * ks + 8 * gq;
                const float* wp = sgw + ((size_t)(g * 128 + t)) * 128 + s0;
                f32x4 a = *(const f32x4*)wp, bb = *(const f32x4*)(wp + 4);
#pragma unroll
                for (int j = 0; j < 4; ++j) { if (s0 + j > t) a[j] = 0.f; if (s0 + 4 + j > t) bb[j] = 0.f; }
                Wf[ks] = __builtin_bit_cast(bf16x8, pack8(a, bb));
            }
        }
        __syncthreads();
#pragma unroll
        for (int it = 0; it < 4; ++it) {
            const int row = it * 32 + r0;
            const u32x4 v = gv[it];
            const f32x2 ms = st[row];
            f32x4 a = {bflo(v.x), bfhi(v.x), bflo(v.y), bfhi(v.y)}, bb = {bflo(v.z), bfhi(v.z), bflo(v.w), bfhi(v.w)};
            a = (a - ms.x) * ms.y * g0 + b0; bb = (bb - ms.x) * ms.y * g1 + b1;
            *(LAS u32x4*)(Yl + row * KV_STRIDE + c * 16) = pack8(a, bb);
        }
        bf16* up = U + (t0 + t) * AW + g * 128 + 4 * gq;
        u32x2 uv[8];
#pragma unroll
        for (int ct = 0; ct < 8; ++ct) uv[ct] = *(const u32x2*)(up + 16 * ct);
        const bool has_next = (s + 1 < count);
        if (has_next) { const int ni = item + 1, ng = ni >> 7, nci = ni & 127; spatial_fetch_stats(stats, (size_t)nci * 128, tid, sv); spatial_fetch_gv(GV, (size_t)nci * 128, ng, tid, gv); }
        __syncthreads();
        f32x4 acc[8];
#pragma unroll
        for (int ct = 0; ct < 8; ++ct) acc[ct] = (f32x4){0.f, 0.f, 0.f, 0.f};
#pragma unroll
        for (int ks = 0; ks < 4; ++ks) {
            if (ks <= (w >> 1)) {
                LAS unsigned char* y0 = Yl + (32 * ks + 8 * gq + qq) * KV_STRIDE + 8 * pp;
#pragma unroll
                for (int ct = 0; ct < 8; ++ct) {
                    const bf16x8 yf = tr_pair(y0 + 32 * ct, y0 + 4 * KV_STRIDE + 32 * ct);
                    acc[ct] = __builtin_amdgcn_mfma_f32_16x16x32_bf16(yf, Wf[ks], acc[ct], 0, 0, 0);
                }
            }
        }
#pragma unroll
        for (int ct = 0; ct < 8; ++ct) {
            const f32x4 a = acc[ct] + bias;
            u32x2 o; o.x = pk2(bflo(uv[ct].x) * a[0], bfhi(uv[ct].x) * a[1]); o.y = pk2(bflo(uv[ct].y) * a[2], bfhi(uv[ct].y) * a[3]);
            *(u32x2*)(up + 16 * ct) = o;
        }
        if (has_next) spatial_put_stats(stn, tid, sv);
    }
    __syncthreads();
}

__global__ void __launch_bounds__(NWAVES * 64, 2) mega_fwd(Params p) {
    extern __shared__ __attribute__((aligned(16))) unsigned char lds_raw[];
    LAS unsigned char* lds = (LAS unsigned char*)lds_raw;
    cg::grid_group grid = cg::this_grid();
    const int tid = threadIdx.x, lane = tid & 63, wave = __builtin_amdgcn_readfirstlane(tid >> 6);
    const int G = gridDim.x, bx = blockIdx.x;
    const int NGW = G * NWAVES;
    unsigned char* ws = p.ws;
    const float* x = p.in[0];
    bf16* WIN = (bf16*)(ws + OFF_WIN); bf16* WAO = (bf16*)(ws + OFF_WAO); bf16* WSO = (bf16*)(ws + OFF_WSO); bf16* WO = (bf16*)(ws + OFF_WO);
    bf16* H = (bf16*)(ws + OFF_H);
    bf16* OG = (bf16*)(ws + OFF_H); bf16* OATT = (bf16*)(ws + OFF_H + (size_t)3 * T * 512 * 2);
    f32x2* STATS = (f32x2*)(ws + OFF_STATS); f32x2* ML = (f32x2*)(ws + OFF_ML);
    float* COS = (float*)(ws + OFF_ROPE); float* SIN = COS + SEQ * 16;
    unsigned char* Z = ws + OFF_Z;
    bf16* QB = (bf16*)(Z + ZQ); bf16* KB = (bf16*)(Z + ZK); bf16* VB = (bf16*)(Z + ZV); bf16* GVB = (bf16*)(Z + ZGV); bf16* UB = (bf16*)(Z + ZU);
    bf16* GA = (bf16*)(Z + ZGA); bf16* GS = (bf16*)(Z + ZGS);
    bf16* ACT = (bf16*)(Z + ZACT); bf16* TMP = (bf16*)(Z + ZTMP); bf16* MRG = (bf16*)(Z + ZMRG);
    bf16* WGU = (bf16*)(Z + ZWGU); bf16* WD = (bf16*)(Z + ZWD);
    LAS float* scr = (LAS float*)(lds + wave * TR_SCR);

    unsigned* const gbar = (unsigned*)(ws + OFF_CTL);
    unsigned epoch = 0;
#define GRID_SYNC() do { asm volatile("s_waitcnt vmcnt(0) lgkmcnt(0)" ::: "memory"); __syncthreads(); \
        if (tid == 0) { __builtin_amdgcn_fence(__ATOMIC_RELEASE, "agent"); asm volatile("s_waitcnt vmcnt(0)" ::: "memory"); \
            __hip_atomic_fetch_add(gbar, 1u, __ATOMIC_RELAXED, __HIP_MEMORY_SCOPE_AGENT); \
            const unsigned target = (epoch + 1u) * (unsigned)G; \
            while (__hip_atomic_load(gbar, __ATOMIC_RELAXED, __HIP_MEMORY_SCOPE_AGENT) < target) __builtin_amdgcn_s_sleep(2); \
            __builtin_amdgcn_fence(__ATOMIC_ACQUIRE, "agent"); asm volatile("s_waitcnt vmcnt(0)" ::: "memory"); } \
        ++epoch; __syncthreads(); } while (0)
    if (bx == 0) for (int i = tid; i < 1024; i += NWAVES * 64) __hip_atomic_store(gbar + i, 0u, __ATOMIC_RELAXED, __HIP_MEMORY_SCOPE_AGENT);
    asm volatile("s_waitcnt vmcnt(0) lgkmcnt(0)" ::: "memory");
    grid.sync();
    if (wave == 0) { __builtin_amdgcn_fence(__ATOMIC_ACQUIRE, "agent"); asm volatile("s_waitcnt vmcnt(0)" ::: "memory"); }
    __syncthreads();
    const unsigned xcc = (unsigned)__builtin_amdgcn_s_getreg((3 << 11) | 20) & 0xFu;
    volatile LAS unsigned* misc = (volatile LAS unsigned*)(lds + 140288);
    if (tid == 0) misc[0] = __hip_atomic_fetch_add(gbar + 64 + 64 * (xcc & 7u), 1u, __ATOMIC_RELAXED, __HIP_MEMORY_SCOPE_AGENT);
    int vc = bx;
    int vcu = (G % 8 == 0) ? (bx % 8) * (G / 8) + bx / 8 : bx;
    int gw = vcu * NWAVES + wave;
    {
        constexpr int NIT = 3 * (DM / 64) * (DFF / 64) + (DM / 64) * (NIN / 64);
        for (int it0 = gw; it0 < NIT; it0 += NGW) {
            int it = it0;
            if (transpose_seg(it, p.in[2], DM, DFF, WGU, 1, scr, lane)) continue;
            if (transpose_seg(it, p.in[3], DM, DFF, WGU, 2, scr, lane)) continue;
            if (transpose_seg(it, p.in[4], DFF, DM, WD, 0, scr, lane)) continue;
            transpose_seg(it, p.in[6], DM, NIN, WIN, 3, scr, lane);
        }
        for (int pos = bx + G * tid; pos < SEQ; pos += G * 512) {
#pragma unroll
            for (int fi = 0; fi < 16; ++fi) {
                const float ang = (float)pos * p.inv_freq[fi];
                float s, c; sincos_tab((double)ang, s, c);
                COS[pos * 16 + fi] = c; SIN[pos * 16 + fi] = s;
            }
        }
        for (int m = gw; m < T; m += NGW) rms_row_bf16(x + (size_t)m * DM, p.in[1], H + (size_t)m * DM, lane);
    }
    GRID_SYNC();
    {
        if (tid == 0) {
            bool ok = (G % 8 == 0);
            for (int j = 0; j < 8; ++j) ok = ok && (__hip_atomic_load(gbar + 64 + 64 * j, __ATOMIC_RELAXED, __HIP_MEMORY_SCOPE_AGENT) == (unsigned)(G / 8));
            misc[1] = ok ? (misc[0] * 8u + (xcc & 7u)) : (unsigned)bx;
        }
        __syncthreads();
        vc = (int)misc[1];
        __syncthreads();
        vcu = (G % 8 == 0) ? (vc % 8) * (G / 8) + vc / 8 : vc;
        gw = vcu * NWAVES + wave;
    }
    LAS float* const rtab = (LAS float*)(lds + 131072 + 1024);
    float* const SSQ = (float*)(ws + OFF_SSQ);
#define FILL_RTAB(S_, FROM_SSQ) do { pg8::Unit u0_; (void)(S_).next(0, u0_); \
        if (tid < 256) { float r_ = 1.0f; \
            if (FROM_SSQ) { const f32x4* sp_ = (const f32x4*)(SSQ + (size_t)(u0_.pm * 256 + tid) * 32); float s_ = 0.f; \
                _Pragma("unroll") for (int j_ = 0; j_ < 8; ++j_) { const f32x4 v_ = sp_[j_]; s_ += (v_[0] + v_[1]) + (v_[2] + v_[3]); } \
                r_ = 1.0f / sqrtf(s_ * (1.0f / DM) + 1e-6f); } \
            rtab[tid] = r_; } \
        __syncthreads(); } while (0)
#define TILE_SYNC(S_, WORD0) do { pg8::Unit ut_; if (G == 256 && (S_).next(0, ut_)) { unsigned* const pc_ = gbar + (WORD0) + ut_.pm; \
        asm volatile("s_waitcnt vmcnt(0) lgkmcnt(0)" ::: "memory"); __syncthreads(); \
        if (tid == 0) { __builtin_amdgcn_fence(__ATOMIC_RELEASE, "agent"); asm volatile("s_waitcnt vmcnt(0)" ::: "memory"); \
            __hip_atomic_fetch_add(pc_, 1u, __ATOMIC_RELAXED, __HIP_MEMORY_SCOPE_AGENT); \
            while (__hip_atomic_load(pc_, __ATOMIC_RELAXED, __HIP_MEMORY_SCOPE_AGENT) < 4u) __builtin_amdgcn_s_sleep(2); \
            __builtin_amdgcn_fence(__ATOMIC_ACQUIRE, "agent"); asm volatile("s_waitcnt vmcnt(0)" ::: "memory"); } \
        __syncthreads(); } else { GRID_SYNC(); } } while (0)
    {
        pg8::Gemm g{H, WGU, T, 2 * DFF, DM}; pg8::StaticOrder S; S.init(T, 2 * DFF, G, vc);
        FILL_RTAB(S, false);
        EpiSwiGLU E{ACT, rtab};
        pg8::gemm_phase<EpiSwiGLU, pg8::StaticOrder, true, true>(lds, g, S, E);
        TILE_SYNC(S, 640);
    }
    {
        pg8::Gemm g{ACT, WD, T, DM, DFF}; pg8::StaticOrder S; S.init(T, DM, G, vc);
        EpiResidN E{x, p.out, 0.5f, p.in[5], H, SSQ};
        pg8::gemm_phase<EpiResidN, pg8::StaticOrder, true, true>(lds, g, S, E);
    }
    GRID_SYNC();
    {
        pg8::Gemm g{H, WIN, T, NIN, DM}; pg8::StaticOrder S; S.init(T, NIN, G, vc);
        FILL_RTAB(S, true);
        EpiWin E{QB, KB, VB, UB, GVB, GA, GS, STATS, COS, SIN, rtab};
        pg8::gemm_phase<EpiWin, pg8::StaticOrder, true, true>(lds, g, S, E);
        {
            const int nbusy = (G == 256) ? 128 : 0;
            if (vc >= nbusy) {
                constexpr int NIT3 = (512 / 64) * (DM / 64) + (AW / 64) * (DM / 64) + (DM / 64) * (DM / 64);
                for (int it0 = (vc - nbusy) * NWAVES + wave; it0 < NIT3; it0 += (G - nbusy) * NWAVES) {
                    int it = it0;
                    if (transpose_seg(it, p.in[11], 512, DM, WAO, 0, scr, lane)) continue;
                    if (transpose_seg(it, p.in[12], AW, DM, WSO, 0, scr, lane)) continue;
                    transpose_seg(it, p.in[13], DM, DM, WO, 0, scr, lane);
                }
            }
        }
    }
    GRID_SYNC();
    {
        const int per = (1536 + G - 1) / G, first = bx * per, cnt = (1536 - first) < per ? (1536 - first) : per;
        attn_range(QB, KB, VB, OG, ML, lds, first, cnt, tid);
        spatial_range(GVB, UB, STATS, p.in[7], p.in[8], p.in[9], p.in[10], lds, first, cnt, tid);
    }
    GRID_SYNC();
    {
        pg8::Gemm g{OATT, WAO, T, DM, 512}; pg8::StaticOrder S; S.init(T, DM, G, vc);
        { pg8::Unit u0;
          if (S.next(0, u0)) {
    for (int tok = u0.pm * 256 + wave; tok < u0.pm * 256 + 256; tok += NWAVES) {
                const int hh = lane >> 4;
                const f32x2 a0 = ML[((size_t)0 * T + tok) * 4 + hh], a1 = ML[((size_t)1 * T + tok) * 4 + hh], a2 = ML[((size_t)2 * T + tok) * 4 + hh];
                const float M = fmaxf(a0.x, fmaxf(a1.x, a2.x));
                const float w0 = a0.y * __builtin_amdgcn_exp2f(a0.x - M), w1 = a1.y * __builtin_amdgcn_exp2f(a1.x - M), w2 = a2.y * __builtin_amdgcn_exp2f(a2.x - M);
                const float inv = 1.0f / (w0 + w1 + w2);
                const u32x4 o0 = *(const u32x4*)(OG + ((size_t)0 * T + tok) * 512 + lane * 8), o1 = *(const u32x4*)(OG + ((size_t)1 * T + tok) * 512 + lane * 8),
                            o2 = *(const u32x4*)(OG + ((size_t)2 * T + tok) * 512 + lane * 8);
                f32x4 a, b;
                a[0] = w0 * bflo(o0.x) + w1 * bflo(o1.x) + w2 * bflo(o2.x); a[1] = w0 * bfhi(o0.x) + w1 * bfhi(o1.x) + w2 * bfhi(o2.x);
                a[2] = w0 * bflo(o0.y) + w1 * bflo(o1.y) + w2 * bflo(o2.y); a[3] = w0 * bfhi(o0.y) + w1 * bfhi(o1.y) + w2 * bfhi(o2.y);
                b[0] = w0 * bflo(o0.z) + w1 * bflo(o1.z) + w2 * bflo(o2.z); b[1] = w0 * bfhi(o0.z) + w1 * bfhi(o1.z) + w2 * bfhi(o2.z);
                b[2] = w0 * bflo(o0.w) + w1 * bflo(o1.w) + w2 * bflo(o2.w); b[3] = w0 * bfhi(o0.w) + w1 * bfhi(o1.w) + w2 * bfhi(o2.w);
                *(u32x4*)(OATT + (size_t)tok * 512 + lane * 8) = pack8(a * inv, b * inv);
            }
          }
          asm volatile("s_waitcnt vmcnt(0)" ::: "memory"); __syncthreads(); }
        EpiGate<0> E{GA, nullptr, TMP};
        pg8::gemm_phase<EpiGate<0>, pg8::StaticOrder, true, true>(lds, g, S, E);
    }
    {
        pg8::Gemm g{UB, WSO, T, DM, AW}; pg8::StaticOrder S; S.init(T, DM, G, vc);
        EpiGate<1> E{GS, TMP, MRG};
        pg8::gemm_phase<EpiGate<1>, pg8::StaticOrder, true, true>(lds, g, S, E);
    }
    GRID_SYNC();
    {
        constexpr int NIT = 3 * (DM / 64) * (DFF / 64);
        for (int it0 = gw; it0 < NIT; it0 += NGW) {
            int it = it0;
            if (transpose_seg(it, p.in[15], DM, DFF, WGU, 1, scr, lane)) continue;
            if (transpose_seg(it, p.in[16], DM, DFF, WGU, 2, scr, lane)) continue;
            transpose_seg(it, p.in[17], DFF, DM, WD, 0, scr, lane);
        }
        __syncthreads();
        pg8::Gemm g{MRG, WO, T, DM, DM}; pg8::StaticOrder S; S.init(T, DM, G, vc);
        EpiResidN E{p.out, p.out, 1.0f, p.in[14], H, SSQ};
        pg8::gemm_phase<EpiResidN, pg8::StaticOrder, true, true>(lds, g, S, E);
    }
    GRID_SYNC();
    {
        pg8::Gemm g{H, WGU, T, 2 * DFF, DM}; pg8::StaticOrder S; S.init(T, 2 * DFF, G, vc);
        FILL_RTAB(S, true);
        EpiSwiGLU E{ACT, rtab};
        pg8::gemm_phase<EpiSwiGLU, pg8::StaticOrder, true, true>(lds, g, S, E);
        TILE_SYNC(S, 704);
    }
    {
        pg8::Gemm g{ACT, WD, T, DM, DFF}; pg8::StaticOrder S; S.init(T, DM, G, vc);
        EpiResid E{p.out, p.out, 0.5f};
        pg8::gemm_phase<EpiResid, pg8::StaticOrder, true, true>(lds, g, S, E);
        pg8::Unit u0;
        if (G == 256 && S.next(0, u0)) {
            unsigned* const pc = gbar + 576 + u0.pm;
            asm volatile("s_waitcnt vmcnt(0) lgkmcnt(0)" ::: "memory"); __syncthreads();
            if (tid == 0) {
                __builtin_amdgcn_fence(__ATOMIC_RELEASE, "agent"); asm volatile("s_waitcnt vmcnt(0)" ::: "memory");
                misc[2] = __hip_atomic_fetch_add(pc, 1u, __ATOMIC_RELAXED, __HIP_MEMORY_SCOPE_AGENT);
                while (__hip_atomic_load(pc, __ATOMIC_RELAXED, __HIP_MEMORY_SCOPE_AGENT) < 4u) __builtin_amdgcn_s_sleep(2);
                __builtin_amdgcn_fence(__ATOMIC_ACQUIRE, "agent"); asm volatile("s_waitcnt vmcnt(0)" ::: "memory");
            }
            __syncthreads();
            const int q = (int)(misc[2] & 3u);
            for (int r = wave; r < 64; r += NWAVES) { const size_t m = (size_t)u0.pm * 256 + 64 * q + r; rms_row_f32(p.out + m * DM, p.in[18], p.out + m * DM, lane); }
        } else {
            GRID_SYNC();
            for (int m = gw; m < T; m += NGW) rms_row_f32(p.out + (size_t)m * DM, p.in[18], p.out + (size_t)m * DM, lane);
        }
    }
}

extern "C" void kernel_launch(void* const* d_in, const int* in_sizes, int n_in, void* d_out, int out_size, void* d_ws, size_t ws_size, hipStream_t stream) {
    static int grid = 0;
    if (grid == 0) {
        if (n_in != 19 || out_size != T * DM || ws_size < WS_NEED) { fprintf(stderr, "kernel_launch: unexpected shapes (n_in %d out %d ws %zu need %zu)\n", n_in, out_size, ws_size, (size_t)WS_NEED); grid = -1; return; }
        int dev = 0, cus = 0, per_cu = 0;
        (void)hipGetDevice(&dev); (void)hipDeviceGetAttribute(&cus, hipDeviceAttributeMultiprocessorCount, dev);
        if (hipFuncSetAttribute((const void*)mega_fwd, hipFuncAttributeMaxDynamicSharedMemorySize, LDS_BYTES) != hipSuccess) { fprintf(stderr, "kernel_launch: hipFuncSetAttribute failed\n"); }
        if (hipOccupancyMaxActiveBlocksPerMultiprocessor(&per_cu, (const void*)mega_fwd, NWAVES * 64, LDS_BYTES) != hipSuccess || per_cu < 1) per_cu = 1;
        (void)hipGetLastError();
        grid = cus * 1;
        if (grid <= 0) grid = 256;
    }
    if (grid < 0) return;
    Params p{};
    for (int i = 0; i < 19; ++i) p.in[i] = (const float*)d_in[i];
    p.out = (float*)d_out; p.ws = (unsigned char*)d_ws;
    for (int i = 0; i < 16; ++i) p.inv_freq[i] = (float)pow(500000.0, -(double)(2 * i) / 32.0);
    void* args[] = {&p};
    hipError_t e = hipLaunchCooperativeKernel((const void*)mega_fwd, dim3(grid), dim3(NWAVES * 64), args, LDS_BYTES, stream);
    if (e != hipSuccess) fprintf(stderr, "cooperative launch failed: %s (grid %d)\n", hipGetErrorString(e), grid);
}
```

```cpp
#include <hip/hip_runtime.h>
#include <hip/hip_cooperative_groups.h>
#include <cstdio>
#include <cstdint>
#include <cmath>
namespace cg = cooperative_groups;
namespace pg8 {
#define PG8_LAS __attribute__((address_space(3)))
typedef unsigned short bf16_t;
typedef short bf16x8 __attribute__((ext_vector_type(8)));
typedef float f32x4 __attribute__((ext_vector_type(4)));
typedef unsigned u32x4 __attribute__((ext_vector_type(4)));
constexpr int BM = 256, BK = 64, HALF = 128, HTB = HALF * BK * 2  , STAGE_BYTES = 8 * HTB, NXCD = 8, WGM = 8;

__host__ __device__ __forceinline__ int lds_byte(int r, int c) { const int st = (r >> 4) * 2 + (c >> 5), rr = r & 15, cc = c & 31, ob = rr * 64 + cc * 2; return st * 1024 + (ob ^ (((ob >> 9) & 1) << 5)); }
__host__ __device__ __forceinline__ void stage_rc(int b, int& R, int& C) { const int st = b / 1024, sb = b % 1024, swz = sb ^ (((sb >> 9) & 1) << 5); R = (st >> 1) * 16 + swz / 64; C = (st & 1) * 32 + (swz % 64) / 2; }
__host__ __device__ __forceinline__ int perm32(int rho) { const int n = rho >> 4, i = rho & 15; return 8 * (i >> 2) + 4 * n + (i & 3); }

struct Unit { int pm, pn; };
struct Gemm { const bf16_t* A; const bf16_t* Bt; int M, N, K; };

struct StaticOrder {
    int nM, nN, nwg, G, c;
    __host__ __device__ void init(int M, int N, int G_, int c_) { nM = M / BM; nN = N / BM; nwg = nM * nN; G = G_; c = c_; }
    __host__ __device__ bool next(int i, Unit& u) const {
        const long L = (long)i * G + c; if (L >= nwg) return false;
        int wgid = (int)L; { const int q = nwg / NXCD, r = nwg % NXCD, xcd = wgid % NXCD, off = wgid / NXCD; wgid = (xcd < r ? xcd * (q + 1) : r * (q + 1) + (xcd - r) * q) + off; }
        const int nig = WGM * nN, gid = wgid / nig, fm = gid * WGM, gsz = (nM - fm) < WGM ? (nM - fm) : WGM;
        u.pm = fm + ((wgid % nig) % gsz); u.pn = (wgid % nig) / gsz; return true;
    }
    __device__ __forceinline__ void a_ready(const Unit&) const {}
    __device__ __forceinline__ void done(const Unit&) const {}
};
typedef __bf16 bf16x2_t __attribute__((ext_vector_type(2)));
__device__ __forceinline__ unsigned cvt_pk_bf16(float lo, float hi) { const float __attribute__((ext_vector_type(2))) v = {lo, hi}; return __builtin_bit_cast(unsigned, __builtin_convertvector(v, bf16x2_t)); }
typedef float f32x2 __attribute__((ext_vector_type(2)));
__device__ __forceinline__ f32x2 gelu_pk(f32x2 v) {
    const f32x2 av = __builtin_elementwise_abs(v), d = av * 0.2316418882f + 1.0f;
    f32x2 t; t.x = __builtin_amdgcn_rcpf(d.x); t.y = __builtin_amdgcn_rcpf(d.y);
    f32x2 q = t * 0.5307027145f + (-0.7265760135f); q = q * t + 0.7107068705f; q = q * t + (-0.142248368f); q = q * t + 0.127414796f; q = q * t;
    const f32x2 s = (v * v) * (-0.72134752044f);
    f32x2 e; e.x = __builtin_amdgcn_exp2f(s.x); e.y = __builtin_amdgcn_exp2f(s.y);
    const f32x2 m = v * (q * e), r = v - m;
    f32x2 o; o.x = v.x < 0.f ? m.x : r.x; o.y = v.y < 0.f ? m.y : r.y; return o;
}
template <class Epi, class Sched, bool ALIGN_EPI = false, bool SP2 = false>
__device__ __forceinline__ void gemm_phase(PG8_LAS unsigned char* lds, const Gemm g, const Sched& S, const Epi& E) {
    int tid_ = threadIdx.x; asm volatile("" : "+v"(tid_));
    const int tid = tid_, wid = __builtin_amdgcn_readfirstlane(tid >> 6), lane = tid & 63, wr = wid >> 2, wc = wid & 3, fr = lane & 15, fq = lane >> 4;
    const int K = g.K, nt = K / BK;
    unsigned voffA[2], voffB[2];
#pragma unroll
    for (int i = 0; i < 2; ++i) { int R, C; stage_rc(tid * 16 + i * 8192, R, C); const int Rb = Epi::PERM ? ((R & ~31) + perm32(R & 31)) : R;
        voffA[i] = (unsigned)(R * K + C) * 2u; voffB[i] = (unsigned)(Rb * K + C) * 2u; }
    const size_t kstep = (size_t)(BK * 2);
    const size_t hstep = (size_t)HALF * K * 2;
    const size_t tstep = 2 * hstep;
    const unsigned ldsw = (unsigned)wid * 1024u;
    const int aoff = lds_byte(wr * 64 + fr, fq * 8), boff = lds_byte(wc * 32 + fr, fq * 8);
#define PG8_SA(b, h) (((b) * 2 + (h)) * HTB)
#define PG8_SB(b, h) ((4 + (b) * 2 + (h)) * HTB)
#define PG8_STAGE(bufoff, gbase, voff) do { _Pragma("unroll") for (int _i = 0; _i < 2; ++_i) \
        __builtin_amdgcn_global_load_lds((const unsigned*)((const char*)(gbase) + (voff)[_i]), (PG8_LAS unsigned*)(lds + (bufoff) + ldsw + _i * 8192), 16, 0, 0); } while (0)
#define PG8_LDA(dst, b, h) do { _Pragma("unroll") for (int m = 0; m < 4; ++m) _Pragma("unroll") for (int k = 0; k < 2; ++k) dst[m][k] = *(const PG8_LAS bf16x8*)(lds + PG8_SA(b, h) + aoff + m * 2048 + k * 1024); } while (0)
#define PG8_LDB(dst, b, h) do { _Pragma("unroll") for (int n = 0; n < 2; ++n) _Pragma("unroll") for (int k = 0; k < 2; ++k) dst[n][k] = *(const PG8_LAS bf16x8*)(lds + PG8_SB(b, h) + boff + n * 2048 + k * 1024); } while (0)
#define PG8_MMA(ai, bj, At, Bt) do { __builtin_amdgcn_s_setprio(1); _Pragma("unroll") for (int m = 0; m < 4; ++m) _Pragma("unroll") for (int n = 0; n < 2; ++n) _Pragma("unroll") for (int k = 0; k < 2; ++k) \
        acc[ai][bj][m][n] = __builtin_amdgcn_mfma_f32_16x16x32_bf16(Bt[n][k], At[m][k], acc[ai][bj][m][n], 0, 0, 0); __builtin_amdgcn_s_setprio(0); } while (0)
#define PG8_WAIT_V(n) asm volatile("s_waitcnt vmcnt(" #n ")" ::: "memory")
#define PG8_WAIT_L(n) asm volatile("s_waitcnt lgkmcnt(" #n ")" ::: "memory")
#define PG8_BAR __builtin_amdgcn_s_barrier()
#define PG8_SCHED __builtin_amdgcn_sched_barrier(0)
    Unit cur, nxt; int ui = 0;
    if (!S.next(0, cur)) return;
    f32x4 acc[2][2][4][2];
#pragma unroll
    for (int a = 0; a < 2; ++a)
#pragma unroll
        for (int b = 0; b < 2; ++b)
#pragma unroll
            for (int m = 0; m < 4; ++m)
#pragma unroll
                for (int n = 0; n < 2; ++n) acc[a][b][m][n] = (f32x4){0.f, 0.f, 0.f, 0.f};
    bf16x8 At[4][2], B0[2][2], B1[2][2];
    const char* cA = (const char*)g.A + (size_t)cur.pm * tstep; const char* cB = (const char*)g.Bt + (size_t)cur.pn * tstep;
    S.a_ready(cur);
    if constexpr (SP2) {
        PG8_STAGE(PG8_SB(0, 0), cB, voffB); PG8_STAGE(PG8_SB(0, 1), cB + hstep, voffB); PG8_STAGE(PG8_SA(0, 0), cA, voffA); PG8_STAGE(PG8_SA(0, 1), cA + hstep, voffA);
        if (wr == 1) PG8_BAR;
        PG8_WAIT_V(2); PG8_BAR;
        PG8_STAGE(PG8_SB(1, 0), cB + kstep, voffB); PG8_STAGE(PG8_SA(1, 0), cA + kstep, voffA); PG8_STAGE(PG8_SB(1, 1), cB + hstep + kstep, voffB);
        PG8_WAIT_V(6); PG8_BAR;
    } else {
        PG8_STAGE(PG8_SB(0, 0), cB, voffB); PG8_STAGE(PG8_SA(0, 0), cA, voffA); PG8_STAGE(PG8_SB(0, 1), cB + hstep, voffB); PG8_STAGE(PG8_SA(0, 1), cA + hstep, voffA);
        if (wr == 1) PG8_BAR;
        PG8_WAIT_V(4); PG8_BAR;
        PG8_STAGE(PG8_SB(1, 0), cB + kstep, voffB); PG8_STAGE(PG8_SA(1, 0), cA + kstep, voffA); PG8_STAGE(PG8_SB(1, 1), cB + hstep + kstep, voffB);
        PG8_WAIT_V(6); PG8_BAR;
    }
    for (;;) {
        const bool has_next = S.next(ui + 1, nxt);
        const char* nA = has_next ? (const char*)g.A + (size_t)nxt.pm * tstep : cA; const char* nB = has_next ? (const char*)g.Bt + (size_t)nxt.pn * tstep : cB;
        for (int t = 0; t < nt; t += 2) {
            const bool last = (t == nt - 2);
            const char* a1 = cA + (size_t)(t + 1) * kstep;
            const char* a2 = last ? nA : cA + (size_t)(t + 2) * kstep; const char* b2 = last ? nB : cB + (size_t)(t + 2) * kstep;
            const char* a3 = a2 + kstep; const char* b3 = b2 + kstep;
            if (last && has_next) S.a_ready(nxt);
            if constexpr (SP2) {
            PG8_LDB(B0, 0, 0); PG8_LDB(B1, 0, 1); PG8_SCHED; PG8_LDA(At, 0, 0); PG8_STAGE(PG8_SA(1, 1), a1 + hstep, voffA);
            PG8_WAIT_V(8); PG8_WAIT_L(0); PG8_BAR; PG8_MMA(0, 0, At, B0); PG8_MMA(0, 1, At, B1); PG8_BAR; PG8_SCHED;
            PG8_LDA(At, 0, 1); PG8_STAGE(PG8_SB(0, 0), b2, voffB); PG8_STAGE(PG8_SB(0, 1), b2 + hstep, voffB); PG8_STAGE(PG8_SA(0, 0), a2, voffA);
            PG8_WAIT_V(8); PG8_WAIT_L(0); PG8_BAR; PG8_MMA(1, 0, At, B0); PG8_MMA(1, 1, At, B1); PG8_BAR; PG8_SCHED;
            PG8_LDB(B0, 1, 0); PG8_LDB(B1, 1, 1); PG8_SCHED; PG8_LDA(At, 1, 0); PG8_STAGE(PG8_SA(0, 1), a2 + hstep, voffA);
            PG8_WAIT_V(8); PG8_WAIT_L(0); PG8_BAR; PG8_MMA(0, 0, At, B0); PG8_MMA(0, 1, At, B1); PG8_BAR; PG8_SCHED;
            PG8_LDA(At, 1, 1); PG8_STAGE(PG8_SB(1, 0), b3, voffB); PG8_STAGE(PG8_SB(1, 1), b3 + hstep, voffB); PG8_STAGE(PG8_SA(1, 0), a3, voffA);
            PG8_WAIT_V(8); PG8_WAIT_L(0); PG8_BAR; PG8_MMA(1, 0, At, B0); PG8_MMA(1, 1, At, B1); PG8_BAR; PG8_SCHED;
            } else {
            PG8_LDB(B0, 0, 0); PG8_SCHED; PG8_LDA(At, 0, 0); PG8_STAGE(PG8_SA(1, 1), a1 + hstep, voffA);
            PG8_WAIT_L(8); PG8_BAR; PG8_WAIT_L(0); PG8_MMA(0, 0, At, B0); PG8_BAR; PG8_SCHED;
            PG8_LDB(B1, 0, 1); PG8_STAGE(PG8_SB(0, 0), b2, voffB);
            PG8_BAR; PG8_WAIT_L(0); PG8_MMA(0, 1, At, B1); PG8_BAR;
            PG8_LDA(At, 0, 1); PG8_STAGE(PG8_SA(0, 0), a2, voffA);
            PG8_BAR; PG8_WAIT_L(0); PG8_MMA(1, 0, At, B0); PG8_BAR; PG8_SCHED;
            PG8_STAGE(PG8_SB(0, 1), b2 + hstep, voffB);
            PG8_WAIT_V(6); PG8_BAR; PG8_MMA(1, 1, At, B1); PG8_BAR;
            PG8_LDB(B0, 1, 0); PG8_SCHED; PG8_LDA(At, 1, 0); PG8_STAGE(PG8_SA(0, 1), a2 + hstep, voffA);
            PG8_WAIT_L(8); PG8_BAR; PG8_WAIT_L(0); PG8_MMA(0, 0, At, B0); PG8_BAR; PG8_SCHED;
            PG8_LDB(B1, 1, 1); PG8_STAGE(PG8_SB(1, 0), b3, voffB);
            PG8_BAR; PG8_WAIT_L(0); PG8_MMA(0, 1, At, B1); PG8_BAR;
            PG8_LDA(At, 1, 1); PG8_STAGE(PG8_SA(1, 0), a3, voffA);
            PG8_BAR; PG8_WAIT_L(0); PG8_MMA(1, 0, At, B0); PG8_BAR; PG8_SCHED;
            PG8_STAGE(PG8_SB(1, 1), b3 + hstep, voffB);
            PG8_WAIT_V(6); PG8_BAR; PG8_MMA(1, 1, At, B1); PG8_BAR;
            }
        }
        if constexpr (ALIGN_EPI) { if (wr == 0) PG8_BAR; }
        if constexpr (!Epi::AFTER_DRAIN) { E(acc, cur, wr, wc, fr, fq); S.done(cur); }
        if (!has_next) break;
#pragma unroll
        for (int a = 0; a < 2; ++a)
#pragma unroll
            for (int b = 0; b < 2; ++b)
#pragma unroll
                for (int m = 0; m < 4; ++m)
#pragma unroll
                    for (int n = 0; n < 2; ++n) acc[a][b][m][n] = (f32x4){0.f, 0.f, 0.f, 0.f};
        cur = nxt; cA = nA; cB = nB; ++ui;
        if constexpr (ALIGN_EPI) { if (wr == 1) PG8_BAR; }
    }
    PG8_WAIT_V(0);
    if constexpr (!ALIGN_EPI) { if (wr == 0) PG8_BAR; }
    PG8_BAR;
    if constexpr (Epi::AFTER_DRAIN) { E.fused(acc, cur, wr, wc, fr, fq, lds, wid, lane); S.done(cur); }
#undef PG8_SA
#undef PG8_SB
#undef PG8_STAGE
#undef PG8_LDA
#undef PG8_LDB
#undef PG8_MMA
#undef PG8_WAIT_V
#undef PG8_WAIT_L
#undef PG8_BAR
#undef PG8_SCHED
}
}

constexpr int T = 16384, SEQ = 4096, DM = 2048, DFF = 5632, AW = 1536, NIN = 11776, NWAVES = 8;
constexpr int LDS_BYTES = 147456;

#define LAS __attribute__((address_space(3)))
typedef unsigned short bf16;
typedef float f32x4 __attribute__((ext_vector_type(4)));
typedef float f32x2 __attribute__((ext_vector_type(2)));
typedef unsigned u32x4 __attribute__((ext_vector_type(4)));
typedef unsigned u32x2 __attribute__((ext_vector_type(2)));
typedef short bf16x8 __attribute__((ext_vector_type(8)));
typedef short s16x4 __attribute__((ext_vector_type(4)));

constexpr size_t SZ_TA = (size_t)T * AW * 2;
constexpr size_t SZ_TD = (size_t)T * DM * 2;
constexpr size_t OFF_WIN = 0;
constexpr size_t OFF_WAO = OFF_WIN + (size_t)NIN * DM * 2;
constexpr size_t OFF_WSO = OFF_WAO + (size_t)DM * 512 * 2;
constexpr size_t OFF_WO  = OFF_WSO + (size_t)DM * AW * 2;
constexpr size_t OFF_H   = OFF_WO + (size_t)DM * DM * 2;
constexpr size_t OFF_STATS = OFF_H + SZ_TD;
constexpr size_t OFF_ML  = OFF_STATS + (size_t)T * 24 * 8;
constexpr size_t OFF_ROPE = OFF_ML + (size_t)3 * T * 4 * 8;
constexpr size_t OFF_SSQ = OFF_ROPE + (size_t)SEQ * 16 * 2 * 4;
constexpr size_t OFF_Z   = OFF_SSQ + (size_t)T * 32 * 4;
constexpr size_t ZGA = 0, ZGS = SZ_TD, ZQ = 2 * SZ_TD, ZK = ZQ + SZ_TA, ZV = ZQ + 2 * SZ_TA, ZGV = ZQ + 3 * SZ_TA, ZU = ZQ + 4 * SZ_TA, ZEND = ZQ + 5 * SZ_TA;
constexpr size_t ZACT = 0, ZTMP = ZQ, ZMRG = ZQ + SZ_TD, ZWGU = ZGV, ZWD = ZWGU + (size_t)2 * DFF * DM * 2;
constexpr size_t OFF_CTL = OFF_Z + ZEND;
constexpr size_t WS_NEED = OFF_CTL + 4096;
static_assert((size_t)T * DFF * 2 <= ZWGU && ZWD + (size_t)DM * DFF * 2 <= ZEND && ZMRG + SZ_TD <= ZWGU, "ws overlay map");

struct Params {
    const float* in[19];
    float* out;
    unsigned char* ws;
    float inv_freq[16];
};

__device__ __forceinline__ unsigned pk2(float lo, float hi) { return pg8::cvt_pk_bf16(lo, hi); }
__device__ __forceinline__ float bflo(unsigned w) { return __uint_as_float(w << 16); }
__device__ __forceinline__ float bfhi(unsigned w) { return __uint_as_float(w & 0xffff0000u); }
__device__ __forceinline__ float wave_sum(float v) {
#pragma unroll
    for (int o = 1; o < 64; o <<= 1) v += __shfl_xor(v, o);
    return v;
}
__device__ __forceinline__ float fast_sigmoid(float x) { return __builtin_amdgcn_rcpf(1.0f + __builtin_amdgcn_exp2f(-1.4426950408889634f * x)); }
__device__ __forceinline__ f32x4 gelu4(f32x4 v) {
    const f32x2 a = pg8::gelu_pk((f32x2){v[0], v[1]}), b = pg8::gelu_pk((f32x2){v[2], v[3]});
    return (f32x4){a.x, a.y, b.x, b.y};
}
__device__ __forceinline__ u32x4 pack8(f32x4 v0, f32x4 v1) { u32x4 w; w.x = pk2(v0[0], v0[1]); w.y = pk2(v0[2], v0[3]); w.z = pk2(v1[0], v1[1]); w.w = pk2(v1[2], v1[3]); return w; }

typedef pg8::Unit Unit;
struct EpiSwiGLU {
    static constexpr bool PERM = true, AFTER_DRAIN = false;
    bf16* O; const LAS float* rt;
    __device__ __forceinline__ void operator()(const f32x4 (&acc)[2][2][4][2], const Unit& u, int wr, int wc, int fr, int fq) const {
        const int row0 = u.pm * 256 + wr * 64 + fr, col0 = u.pn * 128 + wc * 32 + 8 * fq;
#pragma unroll
        for (int ai = 0; ai < 2; ++ai)
#pragma unroll
            for (int m = 0; m < 4; ++m) {
                bf16* rowp = O + (size_t)(row0 + ai * 128 + m * 16) * DFF + col0;
                const float rr = rt[ai * 128 + wr * 64 + m * 16 + fr];
                f32x4 a, b;
#pragma unroll
                for (int j = 0; j < 4; ++j) {
                    const float g0 = acc[ai][0][m][0][j] * rr, g1 = acc[ai][0][m][1][j] * rr;
                    a[j] = g0 * fast_sigmoid(g0) * (acc[ai][1][m][0][j] * rr);
                    b[j] = g1 * fast_sigmoid(g1) * (acc[ai][1][m][1][j] * rr);
                }
                *(u32x4*)rowp = pack8(a, b);
            }
    }
};
struct EpiResid {
    static constexpr bool PERM = false, AFTER_DRAIN = false;
    const float* R; float* O; float scale;
    __device__ __forceinline__ void operator()(const f32x4 (&acc)[2][2][4][2], const Unit& u, int wr, int wc, int fr, int fq) const {
        const int row0 = u.pm * 256 + wr * 64 + fr, col0 = u.pn * 256 + wc * 32 + 4 * fq;
#pragma unroll
        for (int ai = 0; ai < 2; ++ai)
#pragma unroll
            for (int m = 0; m < 4; ++m) {
                const size_t off = (size_t)(row0 + ai * 128 + m * 16) * DM + col0;
#pragma unroll
                for (int bj = 0; bj < 2; ++bj)
#pragma unroll
                    for (int n = 0; n < 2; ++n) {
                        const f32x4 r = *(const f32x4*)(R + off + bj * 128 + n * 16);
                        *(f32x4*)(O + off + bj * 128 + n * 16) = r + scale * acc[ai][bj][m][n];
                    }
            }
    }
};
struct EpiResidN {
    static constexpr bool PERM = false, AFTER_DRAIN = false;
    const float* R; float* O; float scale; const float* gn; bf16* A2; float* ssq;
    __device__ __forceinline__ void operator()(const f32x4 (&acc)[2][2][4][2], const Unit& u, int wr, int wc, int fr, int fq) const {
        const int row0 = u.pm * 256 + wr * 64 + fr, col0 = u.pn * 256 + wc * 32 + 4 * fq;
        f32x4 gv[2][2];
#pragma unroll
        for (int bj = 0; bj < 2; ++bj)
#pragma unroll
            for (int n = 0; n < 2; ++n) gv[bj][n] = *(const f32x4*)(gn + col0 + bj * 128 + n * 16);
#pragma unroll
        for (int ai = 0; ai < 2; ++ai)
#pragma unroll
            for (int m = 0; m < 4; ++m) {
                const int row = row0 + ai * 128 + m * 16;
                const size_t off = (size_t)row * DM + col0;
                float s = 0.f;
#pragma unroll
                for (int bj = 0; bj < 2; ++bj)
#pragma unroll
                    for (int n = 0; n < 2; ++n) {
                        const f32x4 r = *(const f32x4*)(R + off + bj * 128 + n * 16);
                        const f32x4 o = r + scale * acc[ai][bj][m][n];
                        *(f32x4*)(O + off + bj * 128 + n * 16) = o;
                        s += (o[0] * o[0] + o[1] * o[1]) + (o[2] * o[2] + o[3] * o[3]);
                        const f32x4 w = o * gv[bj][n];
                        u32x2 pw; pw.x = pk2(w[0], w[1]); pw.y = pk2(w[2], w[3]);
                        *(u32x2*)(A2 + off + bj * 128 + n * 16) = pw;
                    }
                s += __shfl_xor(s, 16); s += __shfl_xor(s, 32);
                if (fq == 0) ssq[(size_t)row * 32 + u.pn * 4 + wc] = s;
            }
    }
};
struct EpiWin {
    static constexpr bool PERM = true, AFTER_DRAIN = false;
    bf16 *Q, *Kb, *V, *U, *GV, *GA, *GS; f32x2* stats; const float *cosT, *sinT; const LAS float* rt;
    __device__ __forceinline__ void operator()(const f32x4 (&acc)[2][2][4][2], const Unit& u, int wr, int wc, int fr, int fq) const {
        const int pn = (NIN / 256 - 1) - u.pn, row0 = u.pm * 256 + wr * 64 + fr, cw = wc * 32 + 8 * fq;
        if (pn < 18) {
            bf16* base = Q + (size_t)(pn / 6) * ((size_t)T * AW);
            const int colt = (pn % 6) * 256 + cw;
            const bool rope = (pn < 12) && (wc == 0);
            const float sgn = fq < 2 ? -1.f : 1.f;
#pragma unroll
            for (int ai = 0; ai < 2; ++ai)
#pragma unroll
                for (int m = 0; m < 4; ++m) {
                    const int row = row0 + ai * 128 + m * 16, pos = row & (SEQ - 1);
                    const float rr = rt[ai * 128 + wr * 64 + m * 16 + fr];
#pragma unroll
                    for (int bj = 0; bj < 2; ++bj) {
                        f32x4 v0 = acc[ai][bj][m][0] * rr, v1 = acc[ai][bj][m][1] * rr;
                        if (rope) {
                            f32x4 p0, p1;
#pragma unroll
                            for (int j = 0; j < 4; ++j) { p0[j] = __shfl_xor(v0[j], 32); p1[j] = __shfl_xor(v1[j], 32); }
                            const int i0 = pos * 16 + 8 * (fq & 1);
                            const f32x4 c0 = *(const f32x4*)(cosT + i0), c1 = *(const f32x4*)(cosT + i0 + 4);
                            const f32x4 s0 = *(const f32x4*)(sinT + i0), s1 = *(const f32x4*)(sinT + i0 + 4);
                            v0 = v0 * c0 + sgn * (p0 * s0); v1 = v1 * c1 + sgn * (p1 * s1);
                        }
                        *(u32x4*)(base + (size_t)row * AW + colt + bj * 128) = pack8(v0, v1);
                    }
                }
        } else if (pn < 24) {
            const int colt = (pn - 18) * 256 + cw;
#pragma unroll
            for (int ai = 0; ai < 2; ++ai)
#pragma unroll
                for (int m = 0; m < 4; ++m) {
                    const int row = row0 + ai * 128 + m * 16;
                    const float rr = rt[ai * 128 + wr * 64 + m * 16 + fr];
#pragma unroll
                    for (int bj = 0; bj < 2; ++bj)
                        *(u32x4*)(U + (size_t)row * AW + colt + bj * 128) = pack8(gelu4(acc[ai][bj][m][0] * rr), gelu4(acc[ai][bj][m][1] * rr));
                }
        } else if (pn < 30) {
            const int colt = (pn - 24) * 256 + cw;
#pragma unroll
            for (int ai = 0; ai < 2; ++ai)
#pragma unroll
                for (int m = 0; m < 4; ++m) {
                    const int row = row0 + ai * 128 + m * 16;
                    float s = 0.f, ss = 0.f;
                    const float rr = rt[ai * 128 + wr * 64 + m * 16 + fr];
#pragma unroll
                    for (int bj = 0; bj < 2; ++bj) {
                        const f32x4 a = gelu4(acc[ai][bj][m][0] * rr), b = gelu4(acc[ai][bj][m][1] * rr);
                        s += (a[0] + a[1]) + (a[2] + a[3]) + (b[0] + b[1]) + (b[2] + b[3]);
                        ss += (a[0] * a[0] + a[1] * a[1]) + (a[2] * a[2] + a[3] * a[3]) + (b[0] * b[0] + b[1] * b[1]) + (b[2] * b[2] + b[3] * b[3]);
                        *(u32x4*)(GV + (size_t)row * AW + colt + bj * 128) = pack8(a, b);
                    }
                    s += __shfl_xor(s, 16); s += __shfl_xor(s, 32);
                    ss += __shfl_xor(ss, 16); ss += __shfl_xor(ss, 32);
                    if (fq == 0) stats[(size_t)row * 24 + (pn - 24) * 4 + wc] = (f32x2){s, ss};
                }
        } else {
            bf16* base = GA + (size_t)(pn < 38 ? 0 : 1) * ((size_t)T * DM);
            const int colt = (pn < 38 ? pn - 30 : pn - 38) * 256 + cw;
#pragma unroll
            for (int ai = 0; ai < 2; ++ai)
#pragma unroll
                for (int m = 0; m < 4; ++m) {
                    const int row = row0 + ai * 128 + m * 16;
                    const float rr = rt[ai * 128 + wr * 64 + m * 16 + fr];
#pragma unroll
                    for (int bj = 0; bj < 2; ++bj) {
                        f32x4 a = acc[ai][bj][m][0] * rr, b = acc[ai][bj][m][1] * rr;
#pragma unroll
                        for (int j = 0; j < 4; ++j) { a[j] = fast_sigmoid(a[j]); b[j] = fast_sigmoid(b[j]); }
                        *(u32x4*)(base + (size_t)row * DM + colt + bj * 128) = pack8(a, b);
                    }
                }
        }
    }
};
template <int MODE> struct EpiGate {
    static constexpr bool PERM = true, AFTER_DRAIN = false;
    const bf16* G; const bf16* P; bf16* O;
    __device__ __forceinline__ void operator()(const f32x4 (&acc)[2][2][4][2], const Unit& u, int wr, int wc, int fr, int fq) const {
        const int row0 = u.pm * 256 + wr * 64 + fr, col0 = u.pn * 256 + wc * 32 + 8 * fq;
#pragma unroll
        for (int ai = 0; ai < 2; ++ai)
#pragma unroll
            for (int m = 0; m < 4; ++m) {
                const size_t off = (size_t)(row0 + ai * 128 + m * 16) * DM + col0;
#pragma unroll
                for (int bj = 0; bj < 2; ++bj) {
                    const u32x4 g = *(const u32x4*)(G + off + bj * 128);
                    f32x4 a = acc[ai][bj][m][0], b = acc[ai][bj][m][1];
                    a[0] *= bflo(g.x); a[1] *= bfhi(g.x); a[2] *= bflo(g.y); a[3] *= bfhi(g.y);
                    b[0] *= bflo(g.z); b[1] *= bfhi(g.z); b[2] *= bflo(g.w); b[3] *= bfhi(g.w);
                    if (MODE == 1) {
                        const u32x4 t = *(const u32x4*)(P + off + bj * 128);
                        a[0] += bflo(t.x); a[1] += bfhi(t.x); a[2] += bflo(t.y); a[3] += bfhi(t.y);
                        b[0] += bflo(t.z); b[1] += bfhi(t.z); b[2] += bflo(t.w); b[3] += bfhi(t.w);
                    }
                    *(u32x4*)(O + off + bj * 128) = pack8(a, b);
                }
            }
    }
};

__device__ __forceinline__ float q6(float f) { unsigned u = __float_as_uint(f); u += 0xFFFFu + ((u >> 17) & 1u); u &= 0xFFFE0000u; return __uint_as_float(u); }
constexpr int TR_SCR = 64 * 65 * 4;
__device__ __forceinline__ void transpose_item(const float* W, int K, int N, bf16* WT, int k0, int n0, int drow0, LAS float* scr, int lane) {
    const int cq = lane & 15, rq = lane >> 4;
    f32x4 v[16];
#pragma unroll
    for (int i = 0; i < 16; ++i) v[i] = __builtin_nontemporal_load((const f32x4*)(W + (size_t)(k0 + 4 * i + rq) * N + n0 + 4 * cq));
#pragma unroll
    for (int i = 0; i < 16; ++i) { LAS float* d = scr + (4 * i + rq) * 65 + 4 * cq; d[0] = v[i][0]; d[1] = v[i][1]; d[2] = v[i][2]; d[3] = v[i][3]; }
    asm volatile("s_waitcnt lgkmcnt(0)" ::: "memory");
    const int c = lane & 7;
#pragma unroll
    for (int j = 0; j < 8; ++j) { const int n = (lane >> 3) + 8 * j; const LAS float* s = scr + (8 * c) * 65 + n;
        u32x4 o; o.x = pk2(q6(s[0 * 65]), q6(s[1 * 65])); o.y = pk2(q6(s[2 * 65]), q6(s[3 * 65])); o.z = pk2(q6(s[4 * 65]), q6(s[5 * 65])); o.w = pk2(q6(s[6 * 65]), q6(s[7 * 65]));
        *(u32x4*)(WT + (size_t)(drow0 + n) * K + k0 + 8 * c) = o; }
    asm volatile("s_waitcnt lgkmcnt(0)" ::: "memory");
}
__device__ __forceinline__ bool transpose_seg(int& it, const float* W, int K, int N, bf16* WT, int map, LAS float* scr, int lane) {
    const int nblk = N / 64, nitems = (K / 64) * nblk;
    if (it >= nitems) { it -= nitems; return false; }
    const int kb = it / nblk, nb = it % nblk, n0 = nb * 64;
    const int drow0 = map == 0 ? n0 : (map == 3 ? ((N / 256 - 1 - (n0 >> 8)) * 256 + (n0 & 255)) : ((n0 >> 7) * 256 + (n0 & 127) + (map == 2 ? 128 : 0)));
    transpose_item(W, K, N, WT, kb * 64, n0, drow0, scr, lane);
    return true;
}
__device__ __forceinline__ void rms_row_bf16(const float* xrow, const float* g, bf16* orow, int lane) {
    f32x4 v[8]; float s = 0.f;
#pragma unroll
    for (int j = 0; j < 8; ++j) { v[j] = __builtin_nontemporal_load((const f32x4*)xrow + j * 64 + lane);
        s += (v[j][0] * v[j][0] + v[j][1] * v[j][1]) + (v[j][2] * v[j][2] + v[j][3] * v[j][3]); }
    const float r = 1.0f / sqrtf(wave_sum(s) * (1.0f / DM) + 1e-6f);
#pragma unroll
    for (int j = 0; j < 8; ++j) { const f32x4 gg = ((const f32x4*)g)[j * 64 + lane]; const f32x4 o = v[j] * r * gg;
        u32x2 w; w.x = pk2(o[0], o[1]); w.y = pk2(o[2], o[3]); ((u32x2*)orow)[j * 64 + lane] = w; }
}
__device__ __forceinline__ void rms_row_f32(const float* xrow, const float* g, float* orow, int lane) {
    f32x4 v[8]; float s = 0.f;
#pragma unroll
    for (int j = 0; j < 8; ++j) { v[j] = ((const f32x4*)xrow)[j * 64 + lane]; s += (v[j][0] * v[j][0] + v[j][1] * v[j][1]) + (v[j][2] * v[j][2] + v[j][3] * v[j][3]); }
    const float r = 1.0f / sqrtf(wave_sum(s) * (1.0f / DM) + 1e-6f);
#pragma unroll
    for (int j = 0; j < 8; ++j) { const f32x4 gg = ((const f32x4*)g)[j * 64 + lane]; ((f32x4*)orow)[j * 64 + lane] = v[j] * r * gg; }
}
__device__ __forceinline__ void sincos_tab(double a, float& s, float& c) {
    const double kq = rint(a * 0.63661977236758134308);
    double rd = fma(-kq, 1.57079632679489655800, a); rd = fma(-kq, 6.12323399573676603587e-17, rd);
    const int q = ((int)kq) & 3;
    const float r = (float)rd, r2 = r * r;
    const float sp = r * (1.0f + r2 * (-1.0f / 6.0f + r2 * (1.0f / 120.0f + r2 * (-1.0f / 5040.0f + r2 * (1.0f / 362880.0f + r2 * (-1.0f / 39916800.0f))))));
    const float cp = 1.0f + r2 * (-0.5f + r2 * (1.0f / 24.0f + r2 * (-1.0f / 720.0f + r2 * (1.0f / 40320.0f + r2 * (-1.0f / 3628800.0f + r2 * (1.0f / 479001600.0f))))));
    s = (q == 0) ? sp : (q == 1) ? cp : (q == 2) ? -sp : -cp;
    c = (q == 0) ? cp : (q == 1) ? -sp : (q == 2) ? -cp : sp;
}

constexpr int KV_STRIDE = 272;
constexpr int ATT_V_OFF = 256 * KV_STRIDE;
__device__ __forceinline__ bf16x8 tr_pair(LAS unsigned char* p0, LAS unsigned char* p1) {
    const s16x4 a = __builtin_amdgcn_ds_read_tr16_b64_v4i16((LAS s16x4*)p0);
    const s16x4 b = __builtin_amdgcn_ds_read_tr16_b64_v4i16((LAS s16x4*)p1);
    return (bf16x8){a[0], a[1], a[2], a[3], b[0], b[1], b[2], b[3]};
}
struct AttnIdx { int grp, b, hh, r, n, dsh, colbase; };
__device__ __forceinline__ AttnIdx attn_decode(int item) {
    AttnIdx a; a.grp = item >> 9; a.b = (item >> 7) & 3; a.hh = (item >> 5) & 3; const int rb = item & 31;
    a.dsh = 2 * a.grp; const int nbsh = 5 - 2 * a.grp; a.r = rb >> nbsh; a.n = rb & ((1 << nbsh) - 1); a.colbase = (a.grp * 4 + a.hh) * 128; return a;
}
__device__ __forceinline__ void attn_fetch_block(const bf16* Kb, const bf16* Vb, const AttnIdx& a, int nb, int tid, u32x4 (&kv)[4], u32x4 (&vv)[4]) {
    const int c = tid & 15, r0 = tid >> 4;
#pragma unroll
    for (int it = 0; it < 4; ++it) {
        const int ri = nb * 128 + it * 32 + r0;
        const size_t row = (size_t)a.b * SEQ + (((size_t)ri << a.dsh) + a.r);
        kv[it] = *(const u32x4*)(Kb + row * AW + a.colbase + c * 8); vv[it] = *(const u32x4*)(Vb + row * AW + a.colbase + c * 8);
    }
}
__device__ __forceinline__ void attn_store_block(LAS unsigned char* lds, int half, int tid, const u32x4 (&kv)[4], const u32x4 (&vv)[4]) {
    const int c = tid & 15, r0 = tid >> 4;
#pragma unroll
    for (int it = 0; it < 4; ++it) {
        const int row = half * 128 + it * 32 + r0;
        *(LAS u32x4*)(lds + row * KV_STRIDE + c * 16) = kv[it]; *(LAS u32x4*)(lds + ATT_V_OFF + row * KV_STRIDE + c * 16) = vv[it];
    }
}
__device__ __forceinline__ void attn_zero_block(LAS unsigned char* lds, int half, int tid) {
    const u32x4 z = {0u, 0u, 0u, 0u}; u32x4 kz[4] = {z, z, z, z};
    attn_store_block(lds, half, tid, kz, kz);
}
__device__ __forceinline__ void attn_fetch_q(const bf16* Qb, const AttnIdx& a, int w, int lane, bf16x8 (&Qf)[4]) {
    const int qi = 16 * w + (lane & 15), g = lane >> 4;
    const size_t rowq = (size_t)a.b * SEQ + ((((size_t)a.n * 128 + qi) << a.dsh) + a.r);
#pragma unroll
    for (int ks = 0; ks < 4; ++ks) Qf[ks] = *(const bf16x8*)(Qb + rowq * AW + a.colbase + 32 * ks + 8 * g);
}
__device__ __forceinline__ void attn_range(const bf16* Qb, const bf16* Kb, const bf16* Vb, bf16* OG, f32x2* ML, LAS unsigned char* lds, int first, int count, int tid) {
    if (count <= 0) return;
    const int w = __builtin_amdgcn_readfirstlane(tid >> 6), lane = tid & 63, l15 = lane & 15, g = lane >> 4;
    LAS unsigned char* Kl = lds; LAS unsigned char* Vl = lds + ATT_V_OFF;
    AttnIdx a = attn_decode(first);
    bf16x8 Qf[4];
    {
        u32x4 kv[4], vv[4];
        if (a.n > 0) { attn_fetch_block(Kb, Vb, a, a.n - 1, tid, kv, vv); attn_store_block(lds, (a.n - 1) & 1, tid, kv, vv); }
        else attn_zero_block(lds, 1, tid);
        attn_fetch_block(Kb, Vb, a, a.n, tid, kv, vv); attn_store_block(lds, a.n & 1, tid, kv, vv);
        attn_fetch_q(Qb, a, w, lane, Qf);
    }
    __syncthreads();
    for (int s = 0; s < count; ++s) {
        const bool has_next = (s + 1 < count);
        AttnIdx an = attn_decode(has_next ? first + s + 1 : first + s);
        u32x4 nkv[4], nvv[4]; bf16x8 nQ[4];
        if (has_next) { attn_fetch_block(Kb, Vb, an, an.n, tid, nkv, nvv); attn_fetch_q(Qb, an, w, lane, nQ); }
        const int n = a.n, hc = n & 1, hp = hc ^ 1;
        const int qi = 16 * w + l15;
        const size_t rowq = (size_t)a.b * SEQ + ((((size_t)n * 128 + qi) << a.dsh) + a.r);
        const int tb = w & ~1;
        f32x4 S[10];
#pragma unroll
        for (int tt = 0; tt < 10; ++tt) {
            S[tt] = (f32x4){0.f, 0.f, 0.f, 0.f};
            const int t = tb + tt, lrow = ((t < 8 ? hp : hc) * 128 + (t & 7) * 16 + l15);
#pragma unroll
            for (int ks = 0; ks < 4; ++ks) {
                const bf16x8 kf = *(const LAS bf16x8*)(Kl + lrow * KV_STRIDE + (32 * ks + 8 * g) * 2);
                S[tt] = __builtin_amdgcn_mfma_f32_16x16x32_bf16(kf, Qf[ks], S[tt], 0, 0, 0);
            }
        }
        const float sc = 0.08838834764831845f * 1.4426950408889634f;
        float mx = -INFINITY;
#pragma unroll
        for (int tt = 0; tt < 10; ++tt)
#pragma unroll
            for (int e = 0; e < 4; ++e) {
                const int kj = 16 * (tb + tt) + 4 * g + e;
                const bool valid = (kj >= qi) && (kj <= qi + 128) && (n > 0 || kj >= 128);
                const float sv = valid ? S[tt][e] * sc : -INFINITY;
                S[tt][e] = sv; mx = fmaxf(mx, sv);
            }
        mx = fmaxf(mx, __shfl_xor(mx, 16)); mx = fmaxf(mx, __shfl_xor(mx, 32));
        float l = 0.f;
#pragma unroll
        for (int tt = 0; tt < 10; ++tt)
#pragma unroll
            for (int e = 0; e < 4; ++e) { const float pv = __builtin_amdgcn_exp2f(S[tt][e] - mx); S[tt][e] = pv; l += pv; }
        l += __shfl_xor(l, 16); l += __shfl_xor(l, 32);
        f32x4 O[8];
#pragma unroll
        for (int dt = 0; dt < 8; ++dt) O[dt] = (f32x4){0.f, 0.f, 0.f, 0.f};
        const int qq = l15 >> 2, pp = lane & 3;
#pragma unroll
        for (int kp = 0; kp < 5; ++kp) {
            const u32x4 pw = pack8(S[2 * kp], S[2 * kp + 1]);
            const bf16x8 pf = __builtin_bit_cast(bf16x8, pw);
            const int t0 = tb + 2 * kp;
            LAS unsigned char* v0 = Vl + ((t0 < 8 ? hp : hc) * 128 + (t0 & 7) * 16 + 4 * g + qq) * KV_STRIDE + 8 * pp;
#pragma unroll
            for (int dt = 0; dt < 8; ++dt) {
                const bf16x8 vf = tr_pair(v0 + 32 * dt, v0 + 16 * KV_STRIDE + 32 * dt);
                O[dt] = __builtin_amdgcn_mfma_f32_16x16x32_bf16(vf, pf, O[dt], 0, 0, 0);
            }
        }
        const float inv = 1.0f / l;
        bf16* op = OG + ((size_t)a.grp * T + rowq) * 512 + a.hh * 128 + 4 * g;
#pragma unroll
        for (int dt = 0; dt < 8; ++dt) { const f32x4 o = O[dt] * inv; u32x2 wv; wv.x = pk2(o[0], o[1]); wv.y = pk2(o[2], o[3]); *(u32x2*)(op + 16 * dt) = wv; }
        if (g == 0) ML[((size_t)a.grp * T + rowq) * 4 + a.hh] = (f32x2){mx, l};
        __syncthreads();
        if (has_next) {
            attn_store_block(lds, an.n & 1, tid, nkv, nvv);
            if (an.n == 0) attn_zero_block(lds, 1, tid);
#pragma unroll
            for (int ks = 0; ks < 4; ++ks) Qf[ks] = nQ[ks];
            a = an;
            __syncthreads();
        }
    }
}

__device__ __forceinline__ void spatial_fetch_stats(const f32x2* stats, size_t t0, int tid, f32x2 (&sv)[24]) {
    if (tid < 128) { const f32x2* sp = stats + (t0 + tid) * 24;
#pragma unroll
        for (int j = 0; j < 24; ++j) sv[j] = sp[j]; }
}
__device__ __forceinline__ void spatial_put_stats(LAS f32x2* st, int tid, const f32x2 (&sv)[24]) {
    if (tid < 128) { float s = 0.f, ss = 0.f;
#pragma unroll
        for (int j = 0; j < 24; ++j) { s += sv[j].x; ss += sv[j].y; }
        const float mean = s * (1.0f / AW), var = fmaxf(ss * (1.0f / AW) - mean * mean, 0.f);
        st[tid] = (f32x2){mean, 1.0f / sqrtf(var + 1e-5f)}; }
}
__device__ __forceinline__ void spatial_fetch_gv(const bf16* GV, size_t t0, int g, int tid, u32x4 (&gv)[4]) {
    const int c = tid & 15, r0 = tid >> 4;
#pragma unroll
    for (int it = 0; it < 4; ++it) gv[it] = *(const u32x4*)(GV + (t0 + it * 32 + r0) * AW + g * 128 + c * 8);
}
__device__ __forceinline__ void spatial_range(const bf16* GV, bf16* U, const f32x2* stats, const float* lng, const float* lnb, const float* sgw, const float* sgb,
                                              LAS unsigned char* lds, int first, int count, int tid) {
    if (count <= 0) return;
    const int w = __builtin_amdgcn_readfirstlane(tid >> 6), lane = tid & 63, l15 = lane & 15, gq = lane >> 4;
    LAS unsigned char* Yl = lds; LAS f32x2* stb = (LAS f32x2*)(lds + 128 * KV_STRIDE);
    const int t = 16 * w + l15, qq = l15 >> 2, pp = lane & 3, c = tid & 15, r0 = tid >> 4;
    int cur_g = -1; bf16x8 Wf[4]; f32x4 g0, g1, b0, b1; float bias = 0.f;
    f32x2 sv[24]; u32x4 gv[4];
    { const int g = first >> 7, ci = first & 127; spatial_fetch_stats(stats, (size_t)ci * 128, tid, sv); spatial_fetch_gv(GV, (size_t)ci * 128, g, tid, gv); spatial_put_stats(stb, tid, sv); }
    for (int s = 0; s < count; ++s) {
        const int item = first + s, g = item >> 7, ci = item & 127;
        const size_t t0 = (size_t)ci * 128;
        LAS f32x2* st = stb + (s & 1) * 128; LAS f32x2* stn = stb + ((s + 1) & 1) * 128;
        if (g != cur_g) {
            cur_g = g;
            g0 = *(const f32x4*)(lng + g * 128 + c * 8); g1 = *(const f32x4*)(lng + g * 128 + c * 8 + 4);
            b0 = *(const f32x4*)(lnb + g * 128 + c * 8); b1 = *(const f32x4*)(lnb + g * 128 + c * 8 + 4);
            bias = sgb[g * 128 + t];
#pragma unroll
            for (int ks = 0; ks < 4; ++ks) {
                const int s0 = 32 * ks + 8 * gq;
                const float* wp = sgw + ((size_t)(g * 128 + t)) * 128 + s0;
                f32x4 a = *(const f32x4*)wp, bb = *(const f32x4*)(wp + 4);
#pragma unroll
                for (int j = 0; j < 4; ++j) { if (s0 + j > t) a[j] = 0.f; if (s0 + 4 + j > t) bb[j] = 0.f; }
                Wf[ks] = __builtin_bit_cast(bf16x8, pack8(a, bb));
            }
        }
        __syncthreads();
#pragma unroll
        for (int it = 0; it < 4; ++it) {
            const int row = it * 32 + r0;
            const u32x4 v = gv[it];
            const f32x2 ms = st[row];
            f32x4 a = {bflo(v.x), bfhi(v.x), bflo(v.y), bfhi(v.y)}, bb = {bflo(v.z), bfhi(v.z), bflo(v.w), bfhi(v.w)};
            a = (a - ms.x) * ms.y * g0 + b0; bb = (bb - ms.x) * ms.y * g1 + b1;
            *(LAS u32x4*)(Yl + row * KV_STRIDE + c * 16) = pack8(a, bb);
        }
        bf16* up = U + (t0 + t) * AW + g * 128 + 4 * gq;
        u32x2 uv[8];
#pragma unroll
        for (int ct = 0; ct < 8; ++ct) uv[ct] = *(const u32x2*)(up + 16 * ct);
        const bool has_next = (s + 1 < count);
        if (has_next) { const int ni = item + 1, ng = ni >> 7, nci = ni & 127; spatial_fetch_stats(stats, (size_t)nci * 128, tid, sv); spatial_fetch_gv(GV, (size_t)nci * 128, ng, tid, gv); }
        __syncthreads();
        f32x4 acc[8];
#pragma unroll
        for (int ct = 0; ct < 8; ++ct) acc[ct] = (f32x4){0.f, 0.f, 0.f, 0.f};
#pragma unroll
        for (int ks = 0; ks < 4; ++ks) {
            if (ks <= (w >> 1)) {
                LAS unsigned char* y0 = Yl + (32 * ks + 8 * gq + qq) * KV_STRIDE + 8 * pp;
#pragma unroll
                for (int ct = 0; ct < 8; ++ct) {
                    const bf16x8 yf = tr_pair(y0 + 32 * ct, y0 + 4 * KV_STRIDE + 32 * ct);
                    acc[ct] = __builtin_amdgcn_mfma_f32_16x16x32_bf16(yf, Wf[ks], acc[ct], 0, 0, 0);
                }
            }
        }
#pragma unroll
        for (int ct = 0; ct < 8; ++ct) {
            const f32x4 a = acc[ct] + bias;
            u32x2 o; o.x = pk2(bflo(uv[ct].x) * a[0], bfhi(uv[ct].x) * a[1]); o.y = pk2(bflo(uv[ct].y) * a[2], bfhi(uv[ct].y) * a[3]);
            *(u32x2*)(up + 16 * ct) = o;
        }
        if (has_next) spatial_put_stats(stn, tid, sv);
    }
    __syncthreads();
}

__global__ void __launch_bounds__(NWAVES * 64, 2) mega_fwd(Params p) {
    extern __shared__ __attribute__((aligned(16))) unsigned char lds_raw[];
    LAS unsigned char* lds = (LAS unsigned char*)lds_raw;
    cg::grid_group grid = cg::this_grid();
    const int tid = threadIdx.x, lane = tid & 63, wave = __builtin_amdgcn_readfirstlane(tid >> 6);
    const int G = gridDim.x, bx = blockIdx.x;
    const int NGW = G * NWAVES;
    unsigned char* ws = p.ws;
    const float* x = p.in[0];
    bf16* WIN = (bf16*)(ws + OFF_WIN); bf16* WAO = (bf16*)(ws + OFF_WAO); bf16* WSO = (bf16*)(ws + OFF_WSO); bf16* WO = (bf16*)(ws + OFF_WO);
    bf16* H = (bf16*)(ws + OFF_H);
    bf16* OG = (bf16*)(ws + OFF_H); bf16* OATT = (bf16*)(ws + OFF_H + (size_t)3 * T * 512 * 2);
    f32x2* STATS = (f32x2*)(ws + OFF_STATS); f32x2* ML = (f32x2*)(ws + OFF_ML);
    float* COS = (float*)(ws + OFF_ROPE); float* SIN = COS + SEQ * 16;
    unsigned char* Z = ws + OFF_Z;
    bf16* QB = (bf16*)(Z + ZQ); bf16* KB = (bf16*)(Z + ZK); bf16* VB = (bf16*)(Z + ZV); bf16* GVB = (bf16*)(Z + ZGV); bf16* UB = (bf16*)(Z + ZU);
    bf16* GA = (bf16*)(Z + ZGA); bf16* GS = (bf16*)(Z + ZGS);
    bf16* ACT = (bf16*)(Z + ZACT); bf16* TMP = (bf16*)(Z + ZTMP); bf16* MRG = (bf16*)(Z + ZMRG);
    bf16* WGU = (bf16*)(Z + ZWGU); bf16* WD = (bf16*)(Z + ZWD);
    LAS float* scr = (LAS float*)(lds + wave * TR_SCR);

    unsigned* const gbar = (unsigned*)(ws + OFF_CTL);
    unsigned epoch = 0;
#define GRID_SYNC() do { asm volatile("s_waitcnt vmcnt(0) lgkmcnt(0)" ::: "memory"); __syncthreads(); \
        if (tid == 0) { __builtin_amdgcn_fence(__ATOMIC_RELEASE, "agent"); asm volatile("s_waitcnt vmcnt(0)" ::: "memory"); \
            __hip_atomic_fetch_add(gbar, 1u, __ATOMIC_RELAXED, __HIP_MEMORY_SCOPE_AGENT); \
            const unsigned target = (epoch + 1u) * (unsigned)G; \
            while (__hip_atomic_load(gbar, __ATOMIC_RELAXED, __HIP_MEMORY_SCOPE_AGENT) < target) __builtin_amdgcn_s_sleep(2); \
            __builtin_amdgcn_fence(__ATOMIC_ACQUIRE, "agent"); asm volatile("s_waitcnt vmcnt(0)" ::: "memory"); } \
        ++epoch; __syncthreads(); } while (0)
    if (bx == 0) for (int i = tid; i < 1024; i += NWAVES * 64) __hip_atomic_store(gbar + i, 0u, __ATOMIC_RELAXED, __HIP_MEMORY_SCOPE_AGENT);
    asm volatile("s_waitcnt vmcnt(0) lgkmcnt(0)" ::: "memory");
    grid.sync();
    if (wave == 0) { __builtin_amdgcn_fence(__ATOMIC_ACQUIRE, "agent"); asm volatile("s_waitcnt vmcnt(0)" ::: "memory"); }
    __syncthreads();
    const unsigned xcc = (unsigned)__builtin_amdgcn_s_getreg((3 << 11) | 20) & 0xFu;
    volatile LAS unsigned* misc = (volatile LAS unsigned*)(lds + 140288);
    if (tid == 0) misc[0] = __hip_atomic_fetch_add(gbar + 64 + 64 * (xcc & 7u), 1u, __ATOMIC_RELAXED, __HIP_MEMORY_SCOPE_AGENT);
    int vc = bx;
    int vcu = (G % 8 == 0) ? (bx % 8) * (G / 8) + bx / 8 : bx;
    int gw = vcu * NWAVES + wave;
    {
        constexpr int NIT = 3 * (DM / 64) * (DFF / 64) + (DM / 64) * (NIN / 64);
        for (int it0 = gw; it0 < NIT; it0 += NGW) {
            int it = it0;
            if (transpose_seg(it, p.in[2], DM, DFF, WGU, 1, scr, lane)) continue;
            if (transpose_seg(it, p.in[3], DM, DFF, WGU, 2, scr, lane)) continue;
            if (transpose_seg(it, p.in[4], DFF, DM, WD, 0, scr, lane)) continue;
            transpose_seg(it, p.in[6], DM, NIN, WIN, 3, scr, lane);
        }
        for (int pos = bx + G * tid; pos < SEQ; pos += G * 512) {
#pragma unroll
            for (int fi = 0; fi < 16; ++fi) {
                const float ang = (float)pos * p.inv_freq[fi];
                float s, c; sincos_tab((double)ang, s, c);
                COS[pos * 16 + fi] = c; SIN[pos * 16 + fi] = s;
            }
        }
        for (int m = gw; m < T; m += NGW) rms_row_bf16(x + (size_t)m * DM, p.in[1], H + (size_t)m * DM, lane);
    }
    GRID_SYNC();
    {
        if (tid == 0) {
            bool ok = (G % 8 == 0);
            for (int j = 0; j < 8; ++j) ok = ok && (__hip_atomic_load(gbar + 64 + 64 * j, __ATOMIC_RELAXED, __HIP_MEMORY_SCOPE_AGENT) == (unsigned)(G / 8));
            misc[1] = ok ? (misc[0] * 8u + (xcc & 7u)) : (unsigned)bx;
        }
        __syncthreads();
        vc = (int)misc[1];
        __syncthreads();
        vcu = (G % 8 == 0) ? (vc % 8) * (G / 8) + vc / 8 : vc;
        gw = vcu * NWAVES + wave;
    }
    LAS float* const rtab = (LAS float*)(lds + 131072 + 1024);
    float* const SSQ = (float*)(ws + OFF_SSQ);
#define FILL_RTAB(S_, FROM_SSQ) do { pg8::Unit u0_; (void)(S_).next(0, u0_); \
        if (tid < 256) { float r_ = 1.0f; \
            if (FROM_SSQ) { const f32x4* sp_ = (const f32x4*)(SSQ + (size_t)(u0_.pm * 256 + tid) * 32); float s_ = 0.f; \
                _Pragma("unroll") for (int j_ = 0; j_ < 8; ++j_) { const f32x4 v_ = sp_[j_]; s_ += (v_[0] + v_[1]) + (v_[2] + v_[3]); } \
                r_ = 1.0f / sqrtf(s_ * (1.0f / DM) + 1e-6f); } \
            rtab[tid] = r_; } \
        __syncthreads(); } while (0)
#define TILE_SYNC(S_, WORD0) do { pg8::Unit ut_; if (G == 256 && (S_).next(0, ut_)) { unsigned* const pc_ = gbar + (WORD0) + ut_.pm; \
        asm volatile("s_waitcnt vmcnt(0) lgkmcnt(0)" ::: "memory"); __syncthreads(); \
        if (tid == 0) { __builtin_amdgcn_fence(__ATOMIC_RELEASE, "agent"); asm volatile("s_waitcnt vmcnt(0)" ::: "memory"); \
            __hip_atomic_fetch_add(pc_, 1u, __ATOMIC_RELAXED, __HIP_MEMORY_SCOPE_AGENT); \
            while (__hip_atomic_load(pc_, __ATOMIC_RELAXED, __HIP_MEMORY_SCOPE_AGENT) < 4u) __builtin_amdgcn_s_sleep(2); \
            __builtin_amdgcn_fence(__ATOMIC_ACQUIRE, "agent"); asm volatile("s_waitcnt vmcnt(0)" ::: "memory"); } \
        __syncthreads(); } else { GRID_SYNC(); } } while (0)
    {
        pg8::Gemm g{H, WGU, T, 2 * DFF, DM}; pg8::StaticOrder S; S.init(T, 2 * DFF, G, vc);
        FILL_RTAB(S, false);
        EpiSwiGLU E{ACT, rtab};
        pg8::gemm_phase<EpiSwiGLU, pg8::StaticOrder, true, true>(lds, g, S, E);
        TILE_SYNC(S, 640);
    }
    {
        pg8::Gemm g{ACT, WD, T, DM, DFF}; pg8::StaticOrder S; S.init(T, DM, G, vc);
        EpiResidN E{x, p.out, 0.5f, p.in[5], H, SSQ};
        pg8::gemm_phase<EpiResidN, pg8::StaticOrder, true, true>(lds, g, S, E);
    }
    GRID_SYNC();
    {
        pg8::Gemm g{H, WIN, T, NIN, DM}; pg8::StaticOrder S; S.init(T, NIN, G, vc);
        FILL_RTAB(S, true);
        EpiWin E{QB, KB, VB, UB, GVB, GA, GS, STATS, COS, SIN, rtab};
        pg8::gemm_phase<EpiWin, pg8::StaticOrder, true, true>(lds, g, S, E);
        {
            const int nbusy = (G == 256) ? 128 : 0;
            if (vc >= nbusy) {
                constexpr int NIT3 = (512 / 64) * (DM / 64) + (AW / 64) * (DM / 64) + (DM / 64) * (DM / 64);
                for (int it0 = (vc - nbusy) * NWAVES + wave; it0 < NIT3; it0 += (G - nbusy) * NWAVES) {
                    int it = it0;
                    if (transpose_seg(it, p.in[11], 512, DM, WAO, 0, scr, lane)) continue;
                    if (transpose_seg(it, p.in[12], AW, DM, WSO, 0, scr, lane)) continue;
                    transpose_seg(it, p.in[13], DM, DM, WO, 0, scr, lane);
                }
            }
        }
    }
    GRID_SYNC();
    {
        const int per = (1536 + G - 1) / G, first = bx * per, cnt = (1536 - first) < per ? (1536 - first) : per;
        attn_range(QB, KB, VB, OG, ML, lds, first, cnt, tid);
        spatial_range(GVB, UB, STATS, p.in[7], p.in[8], p.in[9], p.in[10], lds, first, cnt, tid);
    }
    GRID_SYNC();
    {
        pg8::Gemm g{OATT, WAO, T, DM, 512}; pg8::StaticOrder S; S.init(T, DM, G, vc);
        { pg8::Unit u0;
          if (S.next(0, u0)) {
            const int hh = lane >> 4;
            for (int tb = u0.pm * 256 + wave; tb < u0.pm * 256 + 256; tb += 4 * NWAVES) {
                f32x2 ml[4][3]; u32x4 og[4][3];
#pragma unroll
                for (int k = 0; k < 4; ++k)
#pragma unroll
                    for (int gI = 0; gI < 3; ++gI) { const size_t tok = (size_t)tb + k * NWAVES;
                        ml[k][gI] = ML[((size_t)gI * T + tok) * 4 + hh]; og[k][gI] = *(const u32x4*)(OG + ((size_t)gI * T + tok) * 512 + lane * 8); }
#pragma unroll
                for (int k = 0; k < 4; ++k) {
                    const f32x2 a0 = ml[k][0], a1 = ml[k][1], a2 = ml[k][2]; const u32x4 o0 = og[k][0], o1 = og[k][1], o2 = og[k][2];
                    const float M = fmaxf(a0.x, fmaxf(a1.x, a2.x));
                    const float w0 = a0.y * __builtin_amdgcn_exp2f(a0.x - M), w1 = a1.y * __builtin_amdgcn_exp2f(a1.x - M), w2 = a2.y * __builtin_amdgcn_exp2f(a2.x - M);
                    const float inv = 1.0f / (w0 + w1 + w2);
                    f32x4 a, b;
                    a[0] = w0 * bflo(o0.x) + w1 * bflo(o1.x) + w2 * bflo(o2.x); a[1] = w0 * bfhi(o0.x) + w1 * bfhi(o1.x) + w2 * bfhi(o2.x);
                    a[2] = w0 * bflo(o0.y) + w1 * bflo(o1.y) + w2 * bflo(o2.y); a[3] = w0 * bfhi(o0.y) + w1 * bfhi(o1.y) + w2 * bfhi(o2.y);
                    b[0] = w0 * bflo(o0.z) + w1 * bflo(o1.z) + w2 * bflo(o2.z); b[1] = w0 * bfhi(o0.z) + w1 * bfhi(o1.z) + w2 * bfhi(o2.z);
                    b[2] = w0 * bflo(o0.w) + w1 * bflo(o1.w) + w2 * bflo(o2.w); b[3] = w0 * bfhi(o0.w) + w1 * bfhi(o1.w) + w2 * bfhi(o2.w);
                    *(u32x4*)(OATT + ((size_t)tb + k * NWAVES) * 512 + lane * 8) = pack8(a * inv, b * inv);
                }
            }
          }
          asm volatile("s_waitcnt vmcnt(0)" ::: "memory"); __syncthreads(); }
        EpiGate<0> E{GA, nullptr, TMP};
        pg8::gemm_phase<EpiGate<0>, pg8::StaticOrder, true, true>(lds, g, S, E);
    }
    {
        pg8::Gemm g{UB, WSO, T, DM, AW}; pg8::StaticOrder S; S.init(T, DM, G, vc);
        EpiGate<1> E{GS, TMP, MRG};
        pg8::gemm_phase<EpiGate<1>, pg8::StaticOrder, true, true>(lds, g, S, E);
    }
    GRID_SYNC();
    {
        constexpr int NIT = 3 * (DM / 64) * (DFF / 64);
        for (int it0 = gw; it0 < NIT; it0 += NGW) {
            int it = it0;
            if (transpose_seg(it, p.in[15], DM, DFF, WGU, 1, scr, lane)) continue;
            if (transpose_seg(it, p.in[16], DM, DFF, WGU, 2, scr, lane)) continue;
            transpose_seg(it, p.in[17], DFF, DM, WD, 0, scr, lane);
        }
        __syncthreads();
        pg8::Gemm g{MRG, WO, T, DM, DM}; pg8::StaticOrder S; S.init(T, DM, G, vc);
        EpiResidN E{p.out, p.out, 1.0f, p.in[14], H, SSQ};
        pg8::gemm_phase<EpiResidN, pg8::StaticOrder, true, true>(lds, g, S, E);
    }
    GRID_SYNC();
    {
        pg8::Gemm g{H, WGU, T, 2 * DFF, DM}; pg8::StaticOrder S; S.init(T, 2 * DFF, G, vc);
        FILL_RTAB(S, true);
        EpiSwiGLU E{ACT, rtab};
        pg8::gemm_phase<EpiSwiGLU, pg8::StaticOrder, true, true>(lds, g, S, E);
        TILE_SYNC(S, 704);
    }
    {
        pg8::Gemm g{ACT, WD, T, DM, DFF}; pg8::StaticOrder S; S.init(T, DM, G, vc);
        EpiResid E{p.out, p.out, 0.5f};
        pg8::gemm_phase<EpiResid, pg8::StaticOrder, true, true>(lds, g, S, E);
        pg8::Unit u0;
        if (G == 256 && S.next(0, u0)) {
            unsigned* const pc = gbar + 576 + u0.pm;
            asm volatile("s_waitcnt vmcnt(0) lgkmcnt(0)" ::: "memory"); __syncthreads();
            if (tid == 0) {
                __builtin_amdgcn_fence(__ATOMIC_RELEASE, "agent"); asm volatile("s_waitcnt vmcnt(0)" ::: "memory");
                misc[2] = __hip_atomic_fetch_add(pc, 1u, __ATOMIC_RELAXED, __HIP_MEMORY_SCOPE_AGENT);
                while (__hip_atomic_load(pc, __ATOMIC_RELAXED, __HIP_MEMORY_SCOPE_AGENT) < 4u) __builtin_amdgcn_s_sleep(2);
                __builtin_amdgcn_fence(__ATOMIC_ACQUIRE, "agent"); asm volatile("s_waitcnt vmcnt(0)" ::: "memory");
            }
            __syncthreads();
            const int q = (int)(misc[2] & 3u);
            for (int r = wave; r < 64; r += NWAVES) { const size_t m = (size_t)u0.pm * 256 + 64 * q + r; rms_row_f32(p.out + m * DM, p.in[18], p.out + m * DM, lane); }
        } else {
            GRID_SYNC();
            for (int m = gw; m < T; m += NGW) rms_row_f32(p.out + (size_t)m * DM, p.in[18], p.out + (size_t)m * DM, lane);
        }
    }
}

extern "C" void kernel_launch(void* const* d_in, const int* in_sizes, int n_in, void* d_out, int out_size, void* d_ws, size_t ws_size, hipStream_t stream) {
    static int grid = 0;
    if (grid == 0) {
        if (n_in != 19 || out_size != T * DM || ws_size < WS_NEED) { fprintf(stderr, "kernel_launch: unexpected shapes (n_in %d out %d ws %zu need %zu)\n", n_in, out_size, ws_size, (size_t)WS_NEED); grid = -1; return; }
        int dev = 0, cus = 0, per_cu = 0;
        (void)hipGetDevice(&dev); (void)hipDeviceGetAttribute(&cus, hipDeviceAttributeMultiprocessorCount, dev);
        if (hipFuncSetAttribute((const void*)mega_fwd, hipFuncAttributeMaxDynamicSharedMemorySize, LDS_BYTES) != hipSuccess) { fprintf(stderr, "kernel_launch: hipFuncSetAttribute failed\n"); }
        if (hipOccupancyMaxActiveBlocksPerMultiprocessor(&per_cu, (const void*)mega_fwd, NWAVES * 64, LDS_BYTES) != hipSuccess || per_cu < 1) per_cu = 1;
        (void)hipGetLastError();
        grid = cus * 1;
        if (grid <= 0) grid = 256;
    }
    if (grid < 0) return;
    Params p{};
    for (int i = 0; i < 19; ++i) p.in[i] = (const float*)d_in[i];
    p.out = (float*)d_out; p.ws = (unsigned char*)d_ws;
    for (int i = 0; i < 16; ++i) p.inv_freq[i] = (float)pow(500000.0, -(double)(2 * i) / 32.0);
    void* args[] = {&p};
    hipError_t e = hipLaunchCooperativeKernel((const void*)mega_fwd, dim3(grid), dim3(NWAVES * 64), args, LDS_BYTES, stream);
    if (e != hipSuccess) fprintf(stderr, "cooperative launch failed: %s (grid %d)\n", hipGetErrorString(e), grid);
}
```

```cpp
#include <hip/hip_runtime.h>
#include <hip/hip_cooperative_groups.h>
#include <cstdio>
#include <cstdint>
#include <cmath>
namespace cg = cooperative_groups;
namespace pg8 {
#define PG8_LAS __attribute__((address_space(3)))
typedef unsigned short bf16_t;
typedef short bf16x8 __attribute__((ext_vector_type(8)));
typedef float f32x4 __attribute__((ext_vector_type(4)));
typedef unsigned u32x4 __attribute__((ext_vector_type(4)));
constexpr int BM = 256, BK = 64, HALF = 128, HTB = HALF * BK * 2  , STAGE_BYTES = 8 * HTB, NXCD = 8, WGM = 8;

__host__ __device__ __forceinline__ int lds_byte(int r, int c) { const int st = (r >> 4) * 2 + (c >> 5), rr = r & 15, cc = c & 31, ob = rr * 64 + cc * 2; return st * 1024 + (ob ^ (((ob >> 9) & 1) << 5)); }
__host__ __device__ __forceinline__ void stage_rc(int b, int& R, int& C) { const int st = b / 1024, sb = b % 1024, swz = sb ^ (((sb >> 9) & 1) << 5); R = (st >> 1) * 16 + swz / 64; C = (st & 1) * 32 + (swz % 64) / 2; }
__host__ __device__ __forceinline__ int perm32(int rho) { const int n = rho >> 4, i = rho & 15; return 8 * (i >> 2) + 4 * n + (i & 3); }

struct Unit { int pm, pn; };
struct Gemm { const bf16_t* A; const bf16_t* Bt; int M, N, K; };

struct StaticOrder {
    int nM, nN, nwg, G, c;
    __host__ __device__ void init(int M, int N, int G_, int c_) { nM = M / BM; nN = N / BM; nwg = nM * nN; G = G_; c = c_; }
    __host__ __device__ bool next(int i, Unit& u) const {
        const long L = (long)i * G + c; if (L >= nwg) return false;
        int wgid = (int)L; { const int q = nwg / NXCD, r = nwg % NXCD, xcd = wgid % NXCD, off = wgid / NXCD; wgid = (xcd < r ? xcd * (q + 1) : r * (q + 1) + (xcd - r) * q) + off; }
        const int nig = WGM * nN, gid = wgid / nig, fm = gid * WGM, gsz = (nM - fm) < WGM ? (nM - fm) : WGM;
        u.pm = fm + ((wgid % nig) % gsz); u.pn = (wgid % nig) / gsz; return true;
    }
    __device__ __forceinline__ void a_ready(const Unit&) const {}
    __device__ __forceinline__ void done(const Unit&) const {}
};
typedef __bf16 bf16x2_t __attribute__((ext_vector_type(2)));
__device__ __forceinline__ unsigned cvt_pk_bf16(float lo, float hi) { const float __attribute__((ext_vector_type(2))) v = {lo, hi}; return __builtin_bit_cast(unsigned, __builtin_convertvector(v, bf16x2_t)); }
typedef float f32x2 __attribute__((ext_vector_type(2)));
__device__ __forceinline__ f32x2 gelu_pk(f32x2 v) {
    const f32x2 av = __builtin_elementwise_abs(v), d = av * 0.2316418882f + 1.0f;
    f32x2 t; t.x = __builtin_amdgcn_rcpf(d.x); t.y = __builtin_amdgcn_rcpf(d.y);
    f32x2 q = t * 0.5307027145f + (-0.7265760135f); q = q * t + 0.7107068705f; q = q * t + (-0.142248368f); q = q * t + 0.127414796f; q = q * t;
    const f32x2 s = (v * v) * (-0.72134752044f);
    f32x2 e; e.x = __builtin_amdgcn_exp2f(s.x); e.y = __builtin_amdgcn_exp2f(s.y);
    const f32x2 m = v * (q * e), r = v - m;
    f32x2 o; o.x = v.x < 0.f ? m.x : r.x; o.y = v.y < 0.f ? m.y : r.y; return o;
}
template <class Epi, class Sched, bool ALIGN_EPI = false, bool SP2 = false>
__device__ __forceinline__ void gemm_phase(PG8_LAS unsigned char* lds, const Gemm g, const Sched& S, const Epi& E) {
    int tid_ = threadIdx.x; asm volatile("" : "+v"(tid_));
    const int tid = tid_, wid = __builtin_amdgcn_readfirstlane(tid >> 6), lane = tid & 63, wr = wid >> 2, wc = wid & 3, fr = lane & 15, fq = lane >> 4;
    const int K = g.K, nt = K / BK;
    unsigned voffA[2], voffB[2];
#pragma unroll
    for (int i = 0; i < 2; ++i) { int R, C; stage_rc(tid * 16 + i * 8192, R, C); const int Rb = Epi::PERM ? ((R & ~31) + perm32(R & 31)) : R;
        voffA[i] = (unsigned)(R * K + C) * 2u; voffB[i] = (unsigned)(Rb * K + C) * 2u; }
    const size_t kstep = (size_t)(BK * 2);
    const size_t hstep = (size_t)HALF * K * 2;
    const size_t tstep = 2 * hstep;
    const unsigned ldsw = (unsigned)wid * 1024u;
    const int aoff = lds_byte(wr * 64 + fr, fq * 8), boff = lds_byte(wc * 32 + fr, fq * 8);
#define PG8_SA(b, h) (((b) * 2 + (h)) * HTB)
#define PG8_SB(b, h) ((4 + (b) * 2 + (h)) * HTB)
#define PG8_STAGE(bufoff, gbase, voff) do { _Pragma("unroll") for (int _i = 0; _i < 2; ++_i) \
        __builtin_amdgcn_global_load_lds((const unsigned*)((const char*)(gbase) + (voff)[_i]), (PG8_LAS unsigned*)(lds + (bufoff) + ldsw + _i * 8192), 16, 0, 0); } while (0)
#define PG8_LDA(dst, b, h) do { _Pragma("unroll") for (int m = 0; m < 4; ++m) _Pragma("unroll") for (int k = 0; k < 2; ++k) dst[m][k] = *(const PG8_LAS bf16x8*)(lds + PG8_SA(b, h) + aoff + m * 2048 + k * 1024); } while (0)
#define PG8_LDB(dst, b, h) do { _Pragma("unroll") for (int n = 0; n < 2; ++n) _Pragma("unroll") for (int k = 0; k < 2; ++k) dst[n][k] = *(const PG8_LAS bf16x8*)(lds + PG8_SB(b, h) + boff + n * 2048 + k * 1024); } while (0)
#define PG8_MMA(ai, bj, At, Bt) do { __builtin_amdgcn_s_setprio(1); _Pragma("unroll") for (int m = 0; m < 4; ++m) _Pragma("unroll") for (int n = 0; n < 2; ++n) _Pragma("unroll") for (int k = 0; k < 2; ++k) \
        acc[ai][bj][m][n] = __builtin_amdgcn_mfma_f32_16x16x32_bf16(Bt[n][k], At[m][k], acc[ai][bj][m][n], 0, 0, 0); __builtin_amdgcn_s_setprio(0); } while (0)
#define PG8_WAIT_V(n) asm volatile("s_waitcnt vmcnt(" #n ")" ::: "memory")
#define PG8_WAIT_L(n) asm volatile("s_waitcnt lgkmcnt(" #n ")" ::: "memory")
#define PG8_BAR __builtin_amdgcn_s_barrier()
#define PG8_SCHED __builtin_amdgcn_sched_barrier(0)
    Unit cur, nxt; int ui = 0;
    if (!S.next(0, cur)) return;
    f32x4 acc[2][2][4][2];
#pragma unroll
    for (int a = 0; a < 2; ++a)
#pragma unroll
        for (int b = 0; b < 2; ++b)
#pragma unroll
            for (int m = 0; m < 4; ++m)
#pragma unroll
                for (int n = 0; n < 2; ++n) acc[a][b][m][n] = (f32x4){0.f, 0.f, 0.f, 0.f};
    bf16x8 At[4][2], B0[2][2], B1[2][2];
    const char* cA = (const char*)g.A + (size_t)cur.pm * tstep; const char* cB = (const char*)g.Bt + (size_t)cur.pn * tstep;
    S.a_ready(cur);
    if constexpr (SP2) {
        PG8_STAGE(PG8_SB(0, 0), cB, voffB); PG8_STAGE(PG8_SB(0, 1), cB + hstep, voffB); PG8_STAGE(PG8_SA(0, 0), cA, voffA); PG8_STAGE(PG8_SA(0, 1), cA + hstep, voffA);
        if (wr == 1) PG8_BAR;
        PG8_WAIT_V(2); PG8_BAR;
        PG8_STAGE(PG8_SB(1, 0), cB + kstep, voffB); PG8_STAGE(PG8_SA(1, 0), cA + kstep, voffA); PG8_STAGE(PG8_SB(1, 1), cB + hstep + kstep, voffB);
        PG8_WAIT_V(6); PG8_BAR;
    } else {
        PG8_STAGE(PG8_SB(0, 0), cB, voffB); PG8_STAGE(PG8_SA(0, 0), cA, voffA); PG8_STAGE(PG8_SB(0, 1), cB + hstep, voffB); PG8_STAGE(PG8_SA(0, 1), cA + hstep, voffA);
        if (wr == 1) PG8_BAR;
        PG8_WAIT_V(4); PG8_BAR;
        PG8_STAGE(PG8_SB(1, 0), cB + kstep, voffB); PG8_STAGE(PG8_SA(1, 0), cA + kstep, voffA); PG8_STAGE(PG8_SB(1, 1), cB + hstep + kstep, voffB);
        PG8_WAIT_V(6); PG8_BAR;
    }
    for (;;) {
        const bool has_next = S.next(ui + 1, nxt);
        const char* nA = has_next ? (const char*)g.A + (size_t)nxt.pm * tstep : cA; const char* nB = has_next ? (const char*)g.Bt + (size_t)nxt.pn * tstep : cB;
        for (int t = 0; t < nt; t += 2) {
            const bool last = (t == nt - 2);
            const char* a1 = cA + (size_t)(t + 1) * kstep;
            const char* a2 = last ? nA : cA + (size_t)(t + 2) * kstep; const char* b2 = last ? nB : cB + (size_t)(t + 2) * kstep;
            const char* a3 = a2 + kstep; const char* b3 = b2 + kstep;
            if (last && has_next) S.a_ready(nxt);
            if constexpr (SP2) {
            PG8_LDB(B0, 0, 0); PG8_LDB(B1, 0, 1); PG8_SCHED; PG8_LDA(At, 0, 0); PG8_STAGE(PG8_SA(1, 1), a1 + hstep, voffA);
            PG8_WAIT_V(8); PG8_WAIT_L(0); PG8_BAR; PG8_MMA(0, 0, At, B0); PG8_MMA(0, 1, At, B1); PG8_BAR; PG8_SCHED;
            PG8_LDA(At, 0, 1); PG8_STAGE(PG8_SB(0, 0), b2, voffB); PG8_STAGE(PG8_SB(0, 1), b2 + hstep, voffB); PG8_STAGE(PG8_SA(0, 0), a2, voffA);
            PG8_WAIT_V(8); PG8_WAIT_L(0); PG8_BAR; PG8_MMA(1, 0, At, B0); PG8_MMA(1, 1, At, B1); PG8_BAR; PG8_SCHED;
            PG8_LDB(B0, 1, 0); PG8_LDB(B1, 1, 1); PG8_SCHED; PG8_LDA(At, 1, 0); PG8_STAGE(PG8_SA(0, 1), a2 + hstep, voffA);
            PG8_WAIT_V(8); PG8_WAIT_L(0); PG8_BAR; PG8_MMA(0, 0, At, B0); PG8_MMA(0, 1, At, B1); PG8_BAR; PG8_SCHED;
            PG8_LDA(At, 1, 1); PG8_STAGE(PG8_SB(1, 0), b3, voffB); PG8_STAGE(PG8_SB(1, 1), b3 + hstep, voffB); PG8_STAGE(PG8_SA(1, 0), a3, voffA);
            PG8_WAIT_V(8); PG8_WAIT_L(0); PG8_BAR; PG8_MMA(1, 0, At, B0); PG8_MMA(1, 1, At, B1); PG8_BAR; PG8_SCHED;
            } else {
            PG8_LDB(B0, 0, 0); PG8_SCHED; PG8_LDA(At, 0, 0); PG8_STAGE(PG8_SA(1, 1), a1 + hstep, voffA);
            PG8_WAIT_L(8); PG8_BAR; PG8_WAIT_L(0); PG8_MMA(0, 0, At, B0); PG8_BAR; PG8_SCHED;
            PG8_LDB(B1, 0, 1); PG8_STAGE(PG8_SB(0, 0), b2, voffB);
            PG8_BAR; PG8_WAIT_L(0); PG8_MMA(0, 1, At, B1); PG8_BAR;
            PG8_LDA(At, 0, 1); PG8_STAGE(PG8_SA(0, 0), a2, voffA);
            PG8_BAR; PG8_WAIT_L(0); PG8_MMA(1, 0, At, B0); PG8_BAR; PG8_SCHED;
            PG8_STAGE(PG8_SB(0, 1), b2 + hstep, voffB);
            PG8_WAIT_V(6); PG8_BAR; PG8_MMA(1, 1, At, B1); PG8_BAR;
            PG8_LDB(B0, 1, 0); PG8_SCHED; PG8_LDA(At, 1, 0); PG8_STAGE(PG8_SA(0, 1), a2 + hstep, voffA);
            PG8_WAIT_L(8); PG8_BAR; PG8_WAIT_L(0); PG8_MMA(0, 0, At, B0); PG8_BAR; PG8_SCHED;
            PG8_LDB(B1, 1, 1); PG8_STAGE(PG8_SB(1, 0), b3, voffB);
            PG8_BAR; PG8_WAIT_L(0); PG8_MMA(0, 1, At, B1); PG8_BAR;
            PG8_LDA(At, 1, 1); PG8_STAGE(PG8_SA(1, 0), a3, voffA);
            PG8_BAR; PG8_WAIT_L(0); PG8_MMA(1, 0, At, B0); PG8_BAR; PG8_SCHED;
            PG8_STAGE(PG8_SB(1, 1), b3 + hstep, voffB);
            PG8_WAIT_V(6); PG8_BAR; PG8_MMA(1, 1, At, B1); PG8_BAR;
            }
        }
        if constexpr (ALIGN_EPI) { if (wr == 0) PG8_BAR; }
        if constexpr (!Epi::AFTER_DRAIN) { E(acc, cur, wr, wc, fr, fq); S.done(cur); }
        if (!has_next) break;
#pragma unroll
        for (int a = 0; a < 2; ++a)
#pragma unroll
            for (int b = 0; b < 2; ++b)
#pragma unroll
                for (int m = 0; m < 4; ++m)
#pragma unroll
                    for (int n = 0; n < 2; ++n) acc[a][b][m][n] = (f32x4){0.f, 0.f, 0.f, 0.f};
        cur = nxt; cA = nA; cB = nB; ++ui;
        if constexpr (ALIGN_EPI) { if (wr == 1) PG8_BAR; }
    }
    PG8_WAIT_V(0);
    if constexpr (!ALIGN_EPI) { if (wr == 0) PG8_BAR; }
    PG8_BAR;
    if constexpr (Epi::AFTER_DRAIN) { E.fused(acc, cur, wr, wc, fr, fq, lds, wid, lane); S.done(cur); }
#undef PG8_SA
#undef PG8_SB
#undef PG8_STAGE
#undef PG8_LDA
#undef PG8_LDB
#undef PG8_MMA
#undef PG8_WAIT_V
#undef PG8_WAIT_L
#undef PG8_BAR
#undef PG8_SCHED
}
}

constexpr int T = 16384, SEQ = 4096, DM = 2048, DFF = 5632, AW = 1536, NIN = 11776, NWAVES = 8;
constexpr int LDS_BYTES = 147456;

#define LAS __attribute__((address_space(3)))
typedef unsigned short bf16;
typedef float f32x4 __attribute__((ext_vector_type(4)));
typedef float f32x2 __attribute__((ext_vector_type(2)));
typedef unsigned u32x4 __attribute__((ext_vector_type(4)));
typedef unsigned u32x2 __attribute__((ext_vector_type(2)));
typedef short bf16x8 __attribute__((ext_vector_type(8)));
typedef short s16x4 __attribute__((ext_vector_type(4)));

constexpr size_t SZ_TA = (size_t)T * AW * 2;
constexpr size_t SZ_TD = (size_t)T * DM * 2;
constexpr size_t OFF_WIN = 0;
constexpr size_t OFF_WAO = OFF_WIN + (size_t)NIN * DM * 2;
constexpr size_t OFF_WSO = OFF_WAO + (size_t)DM * 512 * 2;
constexpr size_t OFF_WO  = OFF_WSO + (size_t)DM * AW * 2;
constexpr size_t OFF_H   = OFF_WO + (size_t)DM * DM * 2;
constexpr size_t OFF_STATS = OFF_H + SZ_TD;
constexpr size_t OFF_ML  = OFF_STATS + (size_t)T * 24 * 8;
constexpr size_t OFF_ROPE = OFF_ML + (size_t)3 * T * 4 * 8;
constexpr size_t OFF_SSQ = OFF_ROPE + (size_t)SEQ * 16 * 2 * 4;
constexpr size_t OFF_Z   = OFF_SSQ + (size_t)T * 32 * 4;
constexpr size_t ZGA = 0, ZGS = SZ_TD, ZQ = 2 * SZ_TD, ZK = ZQ + SZ_TA, ZV = ZQ + 2 * SZ_TA, ZGV = ZQ + 3 * SZ_TA, ZU = ZQ + 4 * SZ_TA, ZEND = ZQ + 5 * SZ_TA;
constexpr size_t ZACT = 0, ZTMP = ZQ, ZMRG = ZQ + SZ_TD, ZWGU = ZGV, ZWD = ZWGU + (size_t)2 * DFF * DM * 2;
constexpr size_t OFF_CTL = OFF_Z + ZEND;
constexpr size_t WS_NEED = OFF_CTL + 4096;
static_assert((size_t)T * DFF * 2 <= ZWGU && ZWD + (size_t)DM * DFF * 2 <= ZEND && ZMRG + SZ_TD <= ZWGU, "ws overlay map");

struct Params {
    const float* in[19];
    float* out;
    unsigned char* ws;
    float inv_freq[16];
};

__device__ __forceinline__ unsigned pk2(float lo, float hi) { return pg8::cvt_pk_bf16(lo, hi); }
__device__ __forceinline__ float bflo(unsigned w) { return __uint_as_float(w << 16); }
__device__ __forceinline__ float bfhi(unsigned w) { return __uint_as_float(w & 0xffff0000u); }
__device__ __forceinline__ float wave_sum(float v) {
#pragma unroll
    for (int o = 1; o < 64; o <<= 1) v += __shfl_xor(v, o);
    return v;
}
__device__ __forceinline__ float fast_sigmoid(float x) { return __builtin_amdgcn_rcpf(1.0f + __builtin_amdgcn_exp2f(-1.4426950408889634f * x)); }
__device__ __forceinline__ f32x4 gelu4(f32x4 v) {
    const f32x2 a = pg8::gelu_pk((f32x2){v[0], v[1]}), b = pg8::gelu_pk((f32x2){v[2], v[3]});
    return (f32x4){a.x, a.y, b.x, b.y};
}
__device__ __forceinline__ u32x4 pack8(f32x4 v0, f32x4 v1) { u32x4 w; w.x = pk2(v0[0], v0[1]); w.y = pk2(v0[2], v0[3]); w.z = pk2(v1[0], v1[1]); w.w = pk2(v1[2], v1[3]); return w; }

typedef pg8::Unit Unit;
struct EpiSwiGLU {
    static constexpr bool PERM = true, AFTER_DRAIN = false;
    bf16* O; const LAS float* rt;
    __device__ __forceinline__ void operator()(const f32x4 (&acc)[2][2][4][2], const Unit& u, int wr, int wc, int fr, int fq) const {
        const int row0 = u.pm * 256 + wr * 64 + fr, col0 = u.pn * 128 + wc * 32 + 8 * fq;
#pragma unroll
        for (int ai = 0; ai < 2; ++ai)
#pragma unroll
            for (int m = 0; m < 4; ++m) {
                bf16* rowp = O + (size_t)(row0 + ai * 128 + m * 16) * DFF + col0;
                const float rr = rt[ai * 128 + wr * 64 + m * 16 + fr];
                f32x4 a, b;
#pragma unroll
                for (int j = 0; j < 4; ++j) {
                    const float g0 = acc[ai][0][m][0][j] * rr, g1 = acc[ai][0][m][1][j] * rr;
                    a[j] = g0 * fast_sigmoid(g0) * (acc[ai][1][m][0][j] * rr);
                    b[j] = g1 * fast_sigmoid(g1) * (acc[ai][1][m][1][j] * rr);
                }
                *(u32x4*)rowp = pack8(a, b);
            }
    }
};
struct EpiResid {
    static constexpr bool PERM = false, AFTER_DRAIN = false;
    const float* R; float* O; float scale;
    __device__ __forceinline__ void operator()(const f32x4 (&acc)[2][2][4][2], const Unit& u, int wr, int wc, int fr, int fq) const {
        const int row0 = u.pm * 256 + wr * 64 + fr, col0 = u.pn * 256 + wc * 32 + 4 * fq;
#pragma unroll
        for (int ai = 0; ai < 2; ++ai)
#pragma unroll
            for (int m = 0; m < 4; ++m) {
                const size_t off = (size_t)(row0 + ai * 128 + m * 16) * DM + col0;
#pragma unroll
                for (int bj = 0; bj < 2; ++bj)
#pragma unroll
                    for (int n = 0; n < 2; ++n) {
                        const f32x4 r = *(const f32x4*)(R + off + bj * 128 + n * 16);
                        *(f32x4*)(O + off + bj * 128 + n * 16) = r + scale * acc[ai][bj][m][n];
                    }
            }
    }
};
struct EpiResidN {
    static constexpr bool PERM = false, AFTER_DRAIN = false;
    const float* R; float* O; float scale; const float* gn; bf16* A2; float* ssq;
    __device__ __forceinline__ void operator()(const f32x4 (&acc)[2][2][4][2], const Unit& u, int wr, int wc, int fr, int fq) const {
        const int row0 = u.pm * 256 + wr * 64 + fr, col0 = u.pn * 256 + wc * 32 + 4 * fq;
        f32x4 gv[2][2];
#pragma unroll
        for (int bj = 0; bj < 2; ++bj)
#pragma unroll
            for (int n = 0; n < 2; ++n) gv[bj][n] = *(const f32x4*)(gn + col0 + bj * 128 + n * 16);
#pragma unroll
        for (int ai = 0; ai < 2; ++ai)
#pragma unroll
            for (int m = 0; m < 4; ++m) {
                const int row = row0 + ai * 128 + m * 16;
                const size_t off = (size_t)row * DM + col0;
                float s = 0.f;
#pragma unroll
                for (int bj = 0; bj < 2; ++bj)
#pragma unroll
                    for (int n = 0; n < 2; ++n) {
                        const f32x4 r = *(const f32x4*)(R + off + bj * 128 + n * 16);
                        const f32x4 o = r + scale * acc[ai][bj][m][n];
                        *(f32x4*)(O + off + bj * 128 + n * 16) = o;
                        s += (o[0] * o[0] + o[1] * o[1]) + (o[2] * o[2] + o[3] * o[3]);
                        const f32x4 w = o * gv[bj][n];
                        u32x2 pw; pw.x = pk2(w[0], w[1]); pw.y = pk2(w[2], w[3]);
                        *(u32x2*)(A2 + off + bj * 128 + n * 16) = pw;
                    }
                s += __shfl_xor(s, 16); s += __shfl_xor(s, 32);
                if (fq == 0) ssq[(size_t)row * 32 + u.pn * 4 + wc] = s;
            }
    }
};
struct EpiWin {
    static constexpr bool PERM = true, AFTER_DRAIN = false;
    bf16 *Q, *Kb, *V, *U, *GV, *GA, *GS; f32x2* stats; const float *cosT, *sinT; const LAS float* rt;
    __device__ __forceinline__ void operator()(const f32x4 (&acc)[2][2][4][2], const Unit& u, int wr, int wc, int fr, int fq) const {
        const int pn = (NIN / 256 - 1) - u.pn, row0 = u.pm * 256 + wr * 64 + fr, cw = wc * 32 + 8 * fq;
        if (pn < 18) {
            bf16* base = Q + (size_t)(pn / 6) * ((size_t)T * AW);
            const int colt = (pn % 6) * 256 + cw;
            const bool rope = (pn < 12) && (wc == 0);
            const float sgn = fq < 2 ? -1.f : 1.f;
#pragma unroll
            for (int ai = 0; ai < 2; ++ai)
#pragma unroll
                for (int m = 0; m < 4; ++m) {
                    const int row = row0 + ai * 128 + m * 16, pos = row & (SEQ - 1);
                    const float rr = rt[ai * 128 + wr * 64 + m * 16 + fr];
#pragma unroll
                    for (int bj = 0; bj < 2; ++bj) {
                        f32x4 v0 = acc[ai][bj][m][0] * rr, v1 = acc[ai][bj][m][1] * rr;
                        if (rope) {
                            f32x4 p0, p1;
#pragma unroll
                            for (int j = 0; j < 4; ++j) { p0[j] = __shfl_xor(v0[j], 32); p1[j] = __shfl_xor(v1[j], 32); }
                            const int i0 = pos * 16 + 8 * (fq & 1);
                            const f32x4 c0 = *(const f32x4*)(cosT + i0), c1 = *(const f32x4*)(cosT + i0 + 4);
                            const f32x4 s0 = *(const f32x4*)(sinT + i0), s1 = *(const f32x4*)(sinT + i0 + 4);
                            v0 = v0 * c0 + sgn * (p0 * s0); v1 = v1 * c1 + sgn * (p1 * s1);
                        }
                        *(u32x4*)(base + (size_t)row * AW + colt + bj * 128) = pack8(v0, v1);
                    }
                }
        } else if (pn < 24) {
            const int colt = (pn - 18) * 256 + cw;
#pragma unroll
            for (int ai = 0; ai < 2; ++ai)
#pragma unroll
                for (int m = 0; m < 4; ++m) {
                    const int row = row0 + ai * 128 + m * 16;
                    const float rr = rt[ai * 128 + wr * 64 + m * 16 + fr];
#pragma unroll
                    for (int bj = 0; bj < 2; ++bj)
                        *(u32x4*)(U + (size_t)row * AW + colt + bj * 128) = pack8(gelu4(acc[ai][bj][m][0] * rr), gelu4(acc[ai][bj][m][1] * rr));
                }
        } else if (pn < 30) {
            const int colt = (pn - 24) * 256 + cw;
#pragma unroll
            for (int ai = 0; ai < 2; ++ai)
#pragma unroll
                for (int m = 0; m < 4; ++m) {
                    const int row = row0 + ai * 128 + m * 16;
                    float s = 0.f, ss = 0.f;
                    const float rr = rt[ai * 128 + wr * 64 + m * 16 + fr];
#pragma unroll
                    for (int bj = 0; bj < 2; ++bj) {
                        const f32x4 a = gelu4(acc[ai][bj][m][0] * rr), b = gelu4(acc[ai][bj][m][1] * rr);
                        s += (a[0] + a[1]) + (a[2] + a[3]) + (b[0] + b[1]) + (b[2] + b[3]);
                        ss += (a[0] * a[0] + a[1] * a[1]) + (a[2] * a[2] + a[3] * a[3]) + (b[0] * b[0] + b[1] * b[1]) + (b[2] * b[2] + b[3] * b[3]);
                        *(u32x4*)(GV + (size_t)row * AW + colt + bj * 128) = pack8(a, b);
                    }
                    s += __shfl_xor(s, 16); s += __shfl_xor(s, 32);
                    ss += __shfl_xor(ss, 16); ss += __shfl_xor(ss, 32);
                    if (fq == 0) stats[(size_t)row * 24 + (pn - 24) * 4 + wc] = (f32x2){s, ss};
                }
        } else {
            bf16* base = GA + (size_t)(pn < 38 ? 0 : 1) * ((size_t)T * DM);
            const int colt = (pn < 38 ? pn - 30 : pn - 38) * 256 + cw;
#pragma unroll
            for (int ai = 0; ai < 2; ++ai)
#pragma unroll
                for (int m = 0; m < 4; ++m) {
                    const int row = row0 + ai * 128 + m * 16;
                    const float rr = rt[ai * 128 + wr * 64 + m * 16 + fr];
#pragma unroll
                    for (int bj = 0; bj < 2; ++bj) {
                        f32x4 a = acc[ai][bj][m][0] * rr, b = acc[ai][bj][m][1] * rr;
#pragma unroll
                        for (int j = 0; j < 4; ++j) { a[j] = fast_sigmoid(a[j]); b[j] = fast_sigmoid(b[j]); }
                        *(u32x4*)(base + (size_t)row * DM + colt + bj * 128) = pack8(a, b);
                    }
                }
        }
    }
};
template <int MODE> struct EpiGate {
    static constexpr bool PERM = true, AFTER_DRAIN = false;
    const bf16* G; const bf16* P; bf16* O;
    __device__ __forceinline__ void operator()(const f32x4 (&acc)[2][2][4][2], const Unit& u, int wr, int wc, int fr, int fq) const {
        const int row0 = u.pm * 256 + wr * 64 + fr, col0 = u.pn * 256 + wc * 32 + 8 * fq;
#pragma unroll
        for (int ai = 0; ai < 2; ++ai)
#pragma unroll
            for (int m = 0; m < 4; ++m) {
                const size_t off = (size_t)(row0 + ai * 128 + m * 16) * DM + col0;
#pragma unroll
                for (int bj = 0; bj < 2; ++bj) {
                    const u32x4 g = *(const u32x4*)(G + off + bj * 128);
                    f32x4 a = acc[ai][bj][m][0], b = acc[ai][bj][m][1];
                    a[0] *= bflo(g.x); a[1] *= bfhi(g.x); a[2] *= bflo(g.y); a[3] *= bfhi(g.y);
                    b[0] *= bflo(g.z); b[1] *= bfhi(g.z); b[2] *= bflo(g.w); b[3] *= bfhi(g.w);
                    if (MODE == 1) {
                        const u32x4 t = *(const u32x4*)(P + off + bj * 128);
                        a[0] += bflo(t.x); a[1] += bfhi(t.x); a[2] += bflo(t.y); a[3] += bfhi(t.y);
                        b[0] += bflo(t.z); b[1] += bfhi(t.z); b[2] += bflo(t.w); b[3] += bfhi(t.w);
                    }
                    *(u32x4*)(O + off + bj * 128) = pack8(a, b);
                }
            }
    }
};

__device__ __forceinline__ float q6(float f) { unsigned u = __float_as_uint(f); u += 0xFFFFu + ((u >> 17) & 1u); u &= 0xFFFE0000u; return __uint_as_float(u); }
constexpr int TR_SCR = 64 * 65 * 4;
__device__ __forceinline__ void transpose_item(const float* W, int K, int N, bf16* WT, int k0, int n0, int drow0, LAS float* scr, int lane) {
    const int cq = lane & 15, rq = lane >> 4;
    f32x4 v[16];
#pragma unroll
    for (int i = 0; i < 16; ++i) v[i] = __builtin_nontemporal_load((const f32x4*)(W + (size_t)(k0 + 4 * i + rq) * N + n0 + 4 * cq));
#pragma unroll
    for (int i = 0; i < 16; ++i) { LAS float* d = scr + (4 * i + rq) * 65 + 4 * cq; d[0] = v[i][0]; d[1] = v[i][1]; d[2] = v[i][2]; d[3] = v[i][3]; }
    asm volatile("s_waitcnt lgkmcnt(0)" ::: "memory");
    const int c = lane & 7;
#pragma unroll
    for (int j = 0; j < 8; ++j) { const int n = (lane >> 3) + 8 * j; const LAS float* s = scr + (8 * c) * 65 + n;
        u32x4 o; o.x = pk2(q6(s[0 * 65]), q6(s[1 * 65])); o.y = pk2(q6(s[2 * 65]), q6(s[3 * 65])); o.z = pk2(q6(s[4 * 65]), q6(s[5 * 65])); o.w = pk2(q6(s[6 * 65]), q6(s[7 * 65]));
        *(u32x4*)(WT + (size_t)(drow0 + n) * K + k0 + 8 * c) = o; }
    asm volatile("s_waitcnt lgkmcnt(0)" ::: "memory");
}
__device__ __forceinline__ bool transpose_seg(int& it, const float* W, int K, int N, bf16* WT, int map, LAS float* scr, int lane) {
    const int nblk = N / 64, nitems = (K / 64) * nblk;
    if (it >= nitems) { it -= nitems; return false; }
    const int kb = it / nblk, nb = it % nblk, n0 = nb * 64;
    const int drow0 = map == 0 ? n0 : (map == 3 ? ((N / 256 - 1 - (n0 >> 8)) * 256 + (n0 & 255)) : ((n0 >> 7) * 256 + (n0 & 127) + (map == 2 ? 128 : 0)));
    transpose_item(W, K, N, WT, kb * 64, n0, drow0, scr, lane);
    return true;
}
__device__ __forceinline__ void rms_row_bf16(const float* xrow, const float* g, bf16* orow, int lane) {
    f32x4 v[8]; float s = 0.f;
#pragma unroll
    for (int j = 0; j < 8; ++j) { v[j] = __builtin_nontemporal_load((const f32x4*)xrow + j * 64 + lane);
        s += (v[j][0] * v[j][0] + v[j][1] * v[j][1]) + (v[j][2] * v[j][2] + v[j][3] * v[j][3]); }
    const float r = 1.0f / sqrtf(wave_sum(s) * (1.0f / DM) + 1e-6f);
#pragma unroll
    for (int j = 0; j < 8; ++j) { const f32x4 gg = ((const f32x4*)g)[j * 64 + lane]; const f32x4 o = v[j] * r * gg;
        u32x2 w; w.x = pk2(o[0], o[1]); w.y = pk2(o[2], o[3]); ((u32x2*)orow)[j * 64 + lane] = w; }
}
__device__ __forceinline__ void rms_row_f32(const float* xrow, const float* g, float* orow, int lane) {
    f32x4 v[8]; float s = 0.f;
#pragma unroll
    for (int j = 0; j < 8; ++j) { v[j] = ((const f32x4*)xrow)[j * 64 + lane]; s += (v[j][0] * v[j][0] + v[j][1] * v[j][1]) + (v[j][2] * v[j][2] + v[j][3] * v[j][3]); }
    const float r = 1.0f / sqrtf(wave_sum(s) * (1.0f / DM) + 1e-6f);
#pragma unroll
    for (int j = 0; j < 8; ++j) { const f32x4 gg = ((const f32x4*)g)[j * 64 + lane]; ((f32x4*)orow)[j * 64 + lane] = v[j] * r * gg; }
}
__device__ __forceinline__ void sincos_tab(double a, float& s, float& c) {
    const double kq = rint(a * 0.63661977236758134308);
    double rd = fma(-kq, 1.57079632679489655800, a); rd = fma(-kq, 6.12323399573676603587e-17, rd);
    const int q = ((int)kq) & 3;
    const float r = (float)rd, r2 = r * r;
    const float sp = r * (1.0f + r2 * (-1.0f / 6.0f + r2 * (1.0f / 120.0f + r2 * (-1.0f / 5040.0f + r2 * (1.0f / 362880.0f + r2 * (-1.0f / 39916800.0f))))));
    const float cp = 1.0f + r2 * (-0.5f + r2 * (1.0f / 24.0f + r2 * (-1.0f / 720.0f + r2 * (1.0f / 40320.0f + r2 * (-1.0f / 3628800.0f + r2 * (1.0f / 479001600.0f))))));
    s = (q == 0) ? sp : (q == 1) ? cp : (q == 2) ? -sp : -cp;
    c = (q == 0) ? cp : (q == 1) ? -sp : (q == 2) ? -cp : sp;
}

constexpr int KV_STRIDE = 272;
constexpr int ATT_V_OFF = 256 * KV_STRIDE;
__device__ __forceinline__ bf16x8 tr_pair(LAS unsigned char* p0, LAS unsigned char* p1) {
    const s16x4 a = __builtin_amdgcn_ds_read_tr16_b64_v4i16((LAS s16x4*)p0);
    const s16x4 b = __builtin_amdgcn_ds_read_tr16_b64_v4i16((LAS s16x4*)p1);
    return (bf16x8){a[0], a[1], a[2], a[3], b[0], b[1], b[2], b[3]};
}
struct AttnIdx { int grp, b, hh, r, n, dsh, colbase; };
__device__ __forceinline__ AttnIdx attn_decode(int item) {
    AttnIdx a; a.grp = item >> 9; a.b = (item >> 7) & 3; a.hh = (item >> 5) & 3; const int rb = item & 31;
    a.dsh = 2 * a.grp; const int nbsh = 5 - 2 * a.grp; a.r = rb >> nbsh; a.n = rb & ((1 << nbsh) - 1); a.colbase = (a.grp * 4 + a.hh) * 128; return a;
}
__device__ __forceinline__ void attn_fetch_block(const bf16* Kb, const bf16* Vb, const AttnIdx& a, int nb, int tid, u32x4 (&kv)[4], u32x4 (&vv)[4]) {
    const int c = tid & 15, r0 = tid >> 4;
#pragma unroll
    for (int it = 0; it < 4; ++it) {
        const int ri = nb * 128 + it * 32 + r0;
        const size_t row = (size_t)a.b * SEQ + (((size_t)ri << a.dsh) + a.r);
        kv[it] = *(const u32x4*)(Kb + row * AW + a.colbase + c * 8); vv[it] = *(const u32x4*)(Vb + row * AW + a.colbase + c * 8);
    }
}
__device__ __forceinline__ void attn_store_block(LAS unsigned char* lds, int half, int tid, const u32x4 (&kv)[4], const u32x4 (&vv)[4]) {
    const int c = tid & 15, r0 = tid >> 4;
#pragma unroll
    for (int it = 0; it < 4; ++it) {
        const int row = half * 128 + it * 32 + r0;
        *(LAS u32x4*)(lds + row * KV_STRIDE + c * 16) = kv[it]; *(LAS u32x4*)(lds + ATT_V_OFF + row * KV_STRIDE + c * 16) = vv[it];
    }
}
__device__ __forceinline__ void attn_zero_block(LAS unsigned char* lds, int half, int tid) {
    const u32x4 z = {0u, 0u, 0u, 0u}; u32x4 kz[4] = {z, z, z, z};
    attn_store_block(lds, half, tid, kz, kz);
}
__device__ __forceinline__ void attn_fetch_q(const bf16* Qb, const AttnIdx& a, int w, int lane, bf16x8 (&Qf)[4]) {
    const int qi = 16 * w + (lane & 15), g = lane >> 4;
    const size_t rowq = (size_t)a.b * SEQ + ((((size_t)a.n * 128 + qi) << a.dsh) + a.r);
#pragma unroll
    for (int ks = 0; ks < 4; ++ks) Qf[ks] = *(const bf16x8*)(Qb + rowq * AW + a.colbase + 32 * ks + 8 * g);
}
__device__ __forceinline__ void attn_range(const bf16* Qb, const bf16* Kb, const bf16* Vb, bf16* OG, f32x2* ML, LAS unsigned char* lds, int first, int count, int tid) {
    if (count <= 0) return;
    const int w = __builtin_amdgcn_readfirstlane(tid >> 6), lane = tid & 63, l15 = lane & 15, g = lane >> 4;
    LAS unsigned char* Kl = lds; LAS unsigned char* Vl = lds + ATT_V_OFF;
    AttnIdx a = attn_decode(first);
    bf16x8 Qf[4];
    {
        u32x4 kv[4], vv[4];
        if (a.n > 0) { attn_fetch_block(Kb, Vb, a, a.n - 1, tid, kv, vv); attn_store_block(lds, (a.n - 1) & 1, tid, kv, vv); }
        else attn_zero_block(lds, 1, tid);
        attn_fetch_block(Kb, Vb, a, a.n, tid, kv, vv); attn_store_block(lds, a.n & 1, tid, kv, vv);
        attn_fetch_q(Qb, a, w, lane, Qf);
    }
    __syncthreads();
    for (int s = 0; s < count; ++s) {
        const bool has_next = (s + 1 < count);
        AttnIdx an = attn_decode(has_next ? first + s + 1 : first + s);
        u32x4 nkv[4], nvv[4]; bf16x8 nQ[4];
        if (has_next) { attn_fetch_block(Kb, Vb, an, an.n, tid, nkv, nvv); attn_fetch_q(Qb, an, w, lane, nQ); }
        const int n = a.n, hc = n & 1, hp = hc ^ 1;
        const int qi = 16 * w + l15;
        const size_t rowq = (size_t)a.b * SEQ + ((((size_t)n * 128 + qi) << a.dsh) + a.r);
        const int tb = w & ~1;
        f32x4 S[10];
#pragma unroll
        for (int tt = 0; tt < 10; ++tt) {
            S[tt] = (f32x4){0.f, 0.f, 0.f, 0.f};
            const int t = tb + tt, lrow = ((t < 8 ? hp : hc) * 128 + (t & 7) * 16 + l15);
#pragma unroll
            for (int ks = 0; ks < 4; ++ks) {
                const bf16x8 kf = *(const LAS bf16x8*)(Kl + lrow * KV_STRIDE + (32 * ks + 8 * g) * 2);
                S[tt] = __builtin_amdgcn_mfma_f32_16x16x32_bf16(kf, Qf[ks], S[tt], 0, 0, 0);
            }
        }
        const float sc = 0.08838834764831845f * 1.4426950408889634f;
        float mx = -INFINITY;
#pragma unroll
        for (int tt = 0; tt < 10; ++tt)
#pragma unroll
            for (int e = 0; e < 4; ++e) {
                const int kj = 16 * (tb + tt) + 4 * g + e;
                const bool valid = (kj >= qi) && (kj <= qi + 128) && (n > 0 || kj >= 128);
                const float sv = valid ? S[tt][e] * sc : -INFINITY;
                S[tt][e] = sv; mx = fmaxf(mx, sv);
            }
        mx = fmaxf(mx, __shfl_xor(mx, 16)); mx = fmaxf(mx, __shfl_xor(mx, 32));
        float l = 0.f;
#pragma unroll
        for (int tt = 0; tt < 10; ++tt)
#pragma unroll
            for (int e = 0; e < 4; ++e) { const float pv = __builtin_amdgcn_exp2f(S[tt][e] - mx); S[tt][e] = pv; l += pv; }
        l += __shfl_xor(l, 16); l += __shfl_xor(l, 32);
        f32x4 O[8];
#pragma unroll
        for (int dt = 0; dt < 8; ++dt) O[dt] = (f32x4){0.f, 0.f, 0.f, 0.f};
        const int qq = l15 >> 2, pp = lane & 3;
#pragma unroll
        for (int kp = 0; kp < 5; ++kp) {
            const u32x4 pw = pack8(S[2 * kp], S[2 * kp + 1]);
            const bf16x8 pf = __builtin_bit_cast(bf16x8, pw);
            const int t0 = tb + 2 * kp;
            LAS unsigned char* v0 = Vl + ((t0 < 8 ? hp : hc) * 128 + (t0 & 7) * 16 + 4 * g + qq) * KV_STRIDE + 8 * pp;
#pragma unroll
            for (int dt = 0; dt < 8; ++dt) {
                const bf16x8 vf = tr_pair(v0 + 32 * dt, v0 + 16 * KV_STRIDE + 32 * dt);
                O[dt] = __builtin_amdgcn_mfma_f32_16x16x32_bf16(vf, pf, O[dt], 0, 0, 0);
            }
        }
        const float inv = 1.0f / l;
        bf16* op = OG + ((size_t)a.grp * T + rowq) * 512 + a.hh * 128 + 4 * g;
#pragma unroll
        for (int dt = 0; dt < 8; ++dt) { const f32x4 o = O[dt] * inv; u32x2 wv; wv.x = pk2(o[0], o[1]); wv.y = pk2(o[2], o[3]); *(u32x2*)(op + 16 * dt) = wv; }
        if (g == 0) ML[((size_t)a.grp * T + rowq) * 4 + a.hh] = (f32x2){mx, l};
        __syncthreads();
        if (has_next) {
            attn_store_block(lds, an.n & 1, tid, nkv, nvv);
            if (an.n == 0) attn_zero_block(lds, 1, tid);
#pragma unroll
            for (int ks = 0; ks < 4; ++ks) Qf[ks] = nQ[ks];
            a = an;
            __syncthreads();
        }
    }
}

__device__ __forceinline__ void spatial_fetch_stats(const f32x2* stats, size_t t0, int tid, f32x2 (&sv)[24]) {
    if (tid < 128) { const f32x2* sp = stats + (t0 + tid) * 24;
#pragma unroll
        for (int j = 0; j < 24; ++j) sv[j] = sp[j]; }
}
__device__ __forceinline__ void spatial_put_stats(LAS f32x2* st, int tid, const f32x2 (&sv)[24]) {
    if (tid < 128) { float s = 0.f, ss = 0.f;
#pragma unroll
        for (int j = 0; j < 24; ++j) { s += sv[j].x; ss += sv[j].y; }
        const float mean = s * (1.0f / AW), var = fmaxf(ss * (1.0f / AW) - mean * mean, 0.f);
        st[tid] = (f32x2){mean, 1.0f / sqrtf(var + 1e-5f)}; }
}
__device__ __forceinline__ void spatial_fetch_gv(const bf16* GV, size_t t0, int g, int tid, u32x4 (&gv)[4]) {
    const int c = tid & 15, r0 = tid >> 4;
#pragma unroll
    for (int it = 0; it < 4; ++it) gv[it] = *(const u32x4*)(GV + (t0 + it * 32 + r0) * AW + g * 128 + c * 8);
}
__device__ __forceinline__ void spatial_range(const bf16* GV, bf16* U, const f32x2* stats, const float* lng, const float* lnb, const float* sgw, const float* sgb,
                                              LAS unsigned char* lds, int first, int count, int tid) {
    if (count <= 0) return;
    const int w = __builtin_amdgcn_readfirstlane(tid >> 6), lane = tid & 63, l15 = lane & 15, gq = lane >> 4;
    LAS unsigned char* Yl = lds; LAS f32x2* stb = (LAS f32x2*)(lds + 128 * KV_STRIDE);
    const int t = 16 * w + l15, qq = l15 >> 2, pp = lane & 3, c = tid & 15, r0 = tid >> 4;
    int cur_g = -1; bf16x8 Wf[4]; f32x4 g0, g1, b0, b1; float bias = 0.f;
    f32x2 sv[24]; u32x4 gv[4];
    { const int g = first >> 7, ci = first & 127; spatial_fetch_stats(stats, (size_t)ci * 128, tid, sv); spatial_fetch_gv(GV, (size_t)ci * 128, g, tid, gv); spatial_put_stats(stb, tid, sv); }
    for (int s = 0; s < count; ++s) {
        const int item = first + s, g = item >> 7, ci = item & 127;
        const size_t t0 = (size_t)ci * 128;
        LAS f32x2* st = stb + (s & 1) * 128; LAS f32x2* stn = stb + ((s + 1) & 1) * 128;
        if (g != cur_g) {
            cur_g = g;
            g0 = *(const f32x4*)(lng + g * 128 + c * 8); g1 = *(const f32x4*)(lng + g * 128 + c * 8 + 4);
            b0 = *(const f32x4*)(lnb + g * 128 + c * 8); b1 = *(const f32x4*)(lnb + g * 128 + c * 8 + 4);
            bias = sgb[g * 128 + t];
#pragma unroll
            for (int ks = 0; ks < 4; ++ks) {
                const int s0 = 32 * ks + 8 * gq;
                const float* wp = sgw + ((size_t)(g * 128 + t)) * 128 + s0;
                f32x4 a = *(const f32x4*)wp, bb = *(const f32x4*)(wp + 4);
#pragma unroll
                for (int j = 0; j < 4; ++j) { if (s0 + j > t) a[j] = 0.f; if (s0 + 4 + j > t) bb[j] = 0.f; }
                Wf[ks] = __builtin_bit_cast(bf16x8, pack8(a, bb));
            }
        }
        __syncthreads();
#pragma unroll
        for (int it = 0; it < 4; ++it) {
            const int row = it * 32 + r0;
            const u32x4 v = gv[it];
            const f32x2 ms = st[row];
            f32x4 a = {bflo(v.x), bfhi(v.x), bflo(v.y), bfhi(v.y)}, bb = {bflo(v.z), bfhi(v.z), bflo(v.w), bfhi(v.w)};
            a = (a - ms.x) * ms.y * g0 + b0; bb = (bb - ms.x) * ms.y * g1 + b1;
            *(LAS u32x4*)(Yl + row * KV_STRIDE + c * 16) = pack8(a, bb);
        }
        bf16* up = U + (t0 + t) * AW + g * 128 + 4 * gq;
        u32x2 uv[8];
#pragma unroll
        for (int ct = 0; ct < 8; ++ct) uv[ct] = *(const u32x2*)(up + 16 * ct);
        const bool has_next = (s + 1 < count);
        if (has_next) { const int ni = item + 1, ng = ni >> 7, nci = ni & 127; spatial_fetch_stats(stats, (size_t)nci * 128, tid, sv); spatial_fetch_gv(GV, (size_t)nci * 128, ng, tid, gv); }
        __syncthreads();
        f32x4 acc[8];
#pragma unroll
        for (int ct = 0; ct < 8; ++ct) acc[ct] = (f32x4){0.f, 0.f, 0.f, 0.f};
#pragma unroll
        for (int ks = 0; ks < 4; ++ks) {
            if (ks <= (w >> 1)) {
                LAS unsigned char* y0 = Yl + (32 * ks + 8 * gq + qq) * KV_STRIDE + 8 * pp;
#pragma unroll
                for (int ct = 0; ct < 8; ++ct) {
                    const bf16x8 yf = tr_pair(y0 + 32 * ct, y0 + 4 * KV_STRIDE + 32 * ct);
                    acc[ct] = __builtin_amdgcn_mfma_f32_16x16x32_bf16(yf, Wf[ks], acc[ct], 0, 0, 0);
                }
            }
        }
#pragma unroll
        for (int ct = 0; ct < 8; ++ct) {
            const f32x4 a = acc[ct] + bias;
            u32x2 o; o.x = pk2(bflo(uv[ct].x) * a[0], bfhi(uv[ct].x) * a[1]); o.y = pk2(bflo(uv[ct].y) * a[2], bfhi(uv[ct].y) * a[3]);
            *(u32x2*)(up + 16 * ct) = o;
        }
        if (has_next) spatial_put_stats(stn, tid, sv);
    }
    __syncthreads();
}

__global__ void __launch_bounds__(NWAVES * 64, 2) mega_fwd(Params p) {
    extern __shared__ __attribute__((aligned(16))) unsigned char lds_raw[];
    LAS unsigned char* lds = (LAS unsigned char*)lds_raw;
    cg::grid_group grid = cg::this_grid();
    const int tid = threadIdx.x, lane = tid & 63, wave = __builtin_amdgcn_readfirstlane(tid >> 6);
    const int G = gridDim.x, bx = blockIdx.x;
    const int NGW = G * NWAVES;
    unsigned char* ws = p.ws;
    const float* x = p.in[0];
    bf16* WIN = (bf16*)(ws + OFF_WIN); bf16* WAO = (bf16*)(ws + OFF_WAO); bf16* WSO = (bf16*)(ws + OFF_WSO); bf16* WO = (bf16*)(ws + OFF_WO);
    bf16* H = (bf16*)(ws + OFF_H);
    bf16* OG = (bf16*)(ws + OFF_H); bf16* OATT = (bf16*)(ws + OFF_H + (size_t)3 * T * 512 * 2);
    f32x2* STATS = (f32x2*)(ws + OFF_STATS); f32x2* ML = (f32x2*)(ws + OFF_ML);
    float* COS = (float*)(ws + OFF_ROPE); float* SIN = COS + SEQ * 16;
    unsigned char* Z = ws + OFF_Z;
    bf16* QB = (bf16*)(Z + ZQ); bf16* KB = (bf16*)(Z + ZK); bf16* VB = (bf16*)(Z + ZV); bf16* GVB = (bf16*)(Z + ZGV); bf16* UB = (bf16*)(Z + ZU);
    bf16* GA = (bf16*)(Z + ZGA); bf16* GS = (bf16*)(Z + ZGS);
    bf16* ACT = (bf16*)(Z + ZACT); bf16* TMP = (bf16*)(Z + ZTMP); bf16* MRG = (bf16*)(Z + ZMRG);
    bf16* WGU = (bf16*)(Z + ZWGU); bf16* WD = (bf16*)(Z + ZWD);
    LAS float* scr = (LAS float*)(lds + wave * TR_SCR);

    unsigned* const gbar = (unsigned*)(ws + OFF_CTL);
    unsigned epoch = 0;
#define GRID_SYNC() do { asm volatile("s_waitcnt vmcnt(0) lgkmcnt(0)" ::: "memory"); __syncthreads(); \
        if (tid == 0) { __builtin_amdgcn_fence(__ATOMIC_RELEASE, "agent"); asm volatile("s_waitcnt vmcnt(0)" ::: "memory"); \
            __hip_atomic_fetch_add(gbar, 1u, __ATOMIC_RELAXED, __HIP_MEMORY_SCOPE_AGENT); \
            const unsigned target = (epoch + 1u) * (unsigned)G; \
            while (__hip_atomic_load(gbar, __ATOMIC_RELAXED, __HIP_MEMORY_SCOPE_AGENT) < target) __builtin_amdgcn_s_sleep(2); \
            __builtin_amdgcn_fence(__ATOMIC_ACQUIRE, "agent"); asm volatile("s_waitcnt vmcnt(0)" ::: "memory"); } \
        ++epoch; __syncthreads(); } while (0)
    if (bx == 0) for (int i = tid; i < 1024; i += NWAVES * 64) __hip_atomic_store(gbar + i, 0u, __ATOMIC_RELAXED, __HIP_MEMORY_SCOPE_AGENT);
    asm volatile("s_waitcnt vmcnt(0) lgkmcnt(0)" ::: "memory");
    grid.sync();
    if (wave == 0) { __builtin_amdgcn_fence(__ATOMIC_ACQUIRE, "agent"); asm volatile("s_waitcnt vmcnt(0)" ::: "memory"); }
    __syncthreads();
    const unsigned xcc = (unsigned)__builtin_amdgcn_s_getreg((3 << 11) | 20) & 0xFu;
    volatile LAS unsigned* misc = (volatile LAS unsigned*)(lds + 140288);
    if (tid == 0) misc[0] = __hip_atomic_fetch_add(gbar + 64 + 64 * (xcc & 7u), 1u, __ATOMIC_RELAXED, __HIP_MEMORY_SCOPE_AGENT);
    int vc = bx;
    int vcu = (G % 8 == 0) ? (bx % 8) * (G / 8) + bx / 8 : bx;
    int gw = vcu * NWAVES + wave;
    {
        constexpr int NIT = 3 * (DM / 64) * (DFF / 64) + (DM / 64) * (NIN / 64);
        for (int it0 = gw; it0 < NIT; it0 += NGW) {
            int it = it0;
            if (transpose_seg(it, p.in[2], DM, DFF, WGU, 1, scr, lane)) continue;
            if (transpose_seg(it, p.in[3], DM, DFF, WGU, 2, scr, lane)) continue;
            if (transpose_seg(it, p.in[4], DFF, DM, WD, 0, scr, lane)) continue;
            transpose_seg(it, p.in[6], DM, NIN, WIN, 3, scr, lane);
        }
        for (int pos = bx + G * tid; pos < SEQ; pos += G * 512) {
#pragma unroll
            for (int fi = 0; fi < 16; ++fi) {
                const float ang = (float)pos * p.inv_freq[fi];
                float s, c; sincos_tab((double)ang, s, c);
                COS[pos * 16 + fi] = c; SIN[pos * 16 + fi] = s;
            }
        }
        for (int m = gw; m < T; m += NGW) rms_row_bf16(x + (size_t)m * DM, p.in[1], H + (size_t)m * DM, lane);
    }
    GRID_SYNC();
    {
        if (tid == 0) {
            bool ok = (G % 8 == 0);
            for (int j = 0; j < 8; ++j) ok = ok && (__hip_atomic_load(gbar + 64 + 64 * j, __ATOMIC_RELAXED, __HIP_MEMORY_SCOPE_AGENT) == (unsigned)(G / 8));
            misc[1] = ok ? (misc[0] * 8u + (xcc & 7u)) : (unsigned)bx;
        }
        __syncthreads();
        vc = (int)misc[1];
        __syncthreads();
        vcu = (G % 8 == 0) ? (vc % 8) * (G / 8) + vc / 8 : vc;
        gw = vcu * NWAVES + wave;
    }
    LAS float* const rtab = (LAS float*)(lds + 131072 + 1024);
    float* const SSQ = (float*)(ws + OFF_SSQ);
#define FILL_RTAB(S_, FROM_SSQ) do { pg8::Unit u0_; (void)(S_).next(0, u0_); \
        if (tid < 256) { float r_ = 1.0f; \
            if (FROM_SSQ) { const f32x4* sp_ = (const f32x4*)(SSQ + (size_t)(u0_.pm * 256 + tid) * 32); float s_ = 0.f; \
                _Pragma("unroll") for (int j_ = 0; j_ < 8; ++j_) { const f32x4 v_ = sp_[j_]; s_ += (v_[0] + v_[1]) + (v_[2] + v_[3]); } \
                r_ = 1.0f / sqrtf(s_ * (1.0f / DM) + 1e-6f); } \
            rtab[tid] = r_; } \
        __syncthreads(); } while (0)
#define TILE_SYNC(S_, WORD0) do { pg8::Unit ut_; if (G == 256 && (S_).next(0, ut_)) { unsigned* const pc_ = gbar + (WORD0) + ut_.pm; \
        asm volatile("s_waitcnt vmcnt(0) lgkmcnt(0)" ::: "memory"); __syncthreads(); \
        if (tid == 0) { __builtin_amdgcn_fence(__ATOMIC_RELEASE, "agent"); asm volatile("s_waitcnt vmcnt(0)" ::: "memory"); \
            __hip_atomic_fetch_add(pc_, 1u, __ATOMIC_RELAXED, __HIP_MEMORY_SCOPE_AGENT); \
            while (__hip_atomic_load(pc_, __ATOMIC_RELAXED, __HIP_MEMORY_SCOPE_AGENT) < 4u) __builtin_amdgcn_s_sleep(2); \
            __builtin_amdgcn_fence(__ATOMIC_ACQUIRE, "agent"); asm volatile("s_waitcnt vmcnt(0)" ::: "memory"); } \
        __syncthreads(); } else { GRID_SYNC(); } } while (0)
    {
        pg8::Gemm g{H, WGU, T, 2 * DFF, DM}; pg8::StaticOrder S; S.init(T, 2 * DFF, G, vc);
        FILL_RTAB(S, false);
        EpiSwiGLU E{ACT, rtab};
        pg8::gemm_phase<EpiSwiGLU, pg8::StaticOrder, true, true>(lds, g, S, E);
        TILE_SYNC(S, 640);
    }
    {
        pg8::Gemm g{ACT, WD, T, DM, DFF}; pg8::StaticOrder S; S.init(T, DM, G, vc);
        EpiResidN E{x, p.out, 0.5f, p.in[5], H, SSQ};
        pg8::gemm_phase<EpiResidN, pg8::StaticOrder, true, true>(lds, g, S, E);
    }
    GRID_SYNC();
    {
        pg8::Gemm g{H, WIN, T, NIN, DM}; pg8::StaticOrder S; S.init(T, NIN, G, vc);
        FILL_RTAB(S, true);
        EpiWin E{QB, KB, VB, UB, GVB, GA, GS, STATS, COS, SIN, rtab};
        pg8::gemm_phase<EpiWin, pg8::StaticOrder, true, true>(lds, g, S, E);
        {
            const int nbusy = (G == 256) ? 128 : 0;
            if (vc >= nbusy) {
                constexpr int NIT3 = (512 / 64) * (DM / 64) + (AW / 64) * (DM / 64) + (DM / 64) * (DM / 64);
                for (int it0 = (vc - nbusy) * NWAVES + wave; it0 < NIT3; it0 += (G - nbusy) * NWAVES) {
                    int it = it0;
                    if (transpose_seg(it, p.in[11], 512, DM, WAO, 0, scr, lane)) continue;
                    if (transpose_seg(it, p.in[12], AW, DM, WSO, 0, scr, lane)) continue;
                    transpose_seg(it, p.in[13], DM, DM, WO, 0, scr, lane);
                }
            }
        }
    }
    GRID_SYNC();
    {
        const int per = (1536 + G - 1) / G, first = bx * per, cnt = (1536 - first) < per ? (1536 - first) : per;
        attn_range(QB, KB, VB, OG, ML, lds, first, cnt, tid);
        spatial_range(GVB, UB, STATS, p.in[7], p.in[8], p.in[9], p.in[10], lds, first, cnt, tid);
    }
    GRID_SYNC();
    {
        pg8::Gemm g{OATT, WAO, T, DM, 512}; pg8::StaticOrder S; S.init(T, DM, G, vc);
        { pg8::Unit u0;
          if (S.next(0, u0)) {
            const int hh = lane >> 4;
            for (int tb = u0.pm * 256 + wave; tb < u0.pm * 256 + 256; tb += 4 * NWAVES) {
                f32x2 ml[4][3]; u32x4 og[4][3];
#pragma unroll
                for (int k = 0; k < 4; ++k)
#pragma unroll
                    for (int gI = 0; gI < 3; ++gI) { const size_t tok = (size_t)tb + k * NWAVES;
                        ml[k][gI] = ML[((size_t)gI * T + tok) * 4 + hh]; og[k][gI] = *(const u32x4*)(OG + ((size_t)gI * T + tok) * 512 + lane * 8); }
#pragma unroll
                for (int k = 0; k < 4; ++k) {
                    const f32x2 a0 = ml[k][0], a1 = ml[k][1], a2 = ml[k][2]; const u32x4 o0 = og[k][0], o1 = og[k][1], o2 = og[k][2];
                    const float M = fmaxf(a0.x, fmaxf(a1.x, a2.x));
                    const float w0 = a0.y * __builtin_amdgcn_exp2f(a0.x - M), w1 = a1.y * __builtin_amdgcn_exp2f(a1.x - M), w2 = a2.y * __builtin_amdgcn_exp2f(a2.x - M);
                    const float inv = 1.0f / (w0 + w1 + w2);
                    f32x4 a, b;
                    a[0] = w0 * bflo(o0.x) + w1 * bflo(o1.x) + w2 * bflo(o2.x); a[1] = w0 * bfhi(o0.x) + w1 * bfhi(o1.x) + w2 * bfhi(o2.x);
                    a[2] = w0 * bflo(o0.y) + w1 * bflo(o1.y) + w2 * bflo(o2.y); a[3] = w0 * bfhi(o0.y) + w1 * bfhi(o1.y) + w2 * bfhi(o2.y);
                    b[0] = w0 * bflo(o0.z) + w1 * bflo(o1.z) + w2 * bflo(o2.z); b[1] = w0 * bfhi(o0.z) + w1 * bfhi(o1.z) + w2 * bfhi(o2.z);
                    b[2] = w0 * bflo(o0.w) + w1 * bflo(o1.w) + w2 * bflo(o2.w); b[3] = w0 * bfhi(o0.w) + w1 * bfhi(o1.w) + w2 * bfhi(o2.w);
                    *(u32x4*)(OATT + ((size_t)tb + k * NWAVES) * 512 + lane * 8) = pack8(a * inv, b * inv);
                }
            }
          }
          asm volatile("s_waitcnt vmcnt(0)" ::: "memory"); __syncthreads(); }
        EpiGate<0> E{GA, nullptr, TMP};
        pg8::gemm_phase<EpiGate<0>, pg8::StaticOrder, true, true>(lds, g, S, E);
        if (tid == 0) __hip_atomic_fetch_add(gbar + 960, 1u, __ATOMIC_RELAXED, __HIP_MEMORY_SCOPE_AGENT);
    }
    {
        pg8::Gemm g{UB, WSO, T, DM, AW}; pg8::StaticOrder S; S.init(T, DM, G, vc);
        EpiGate<1> E{GS, TMP, MRG};
        pg8::gemm_phase<EpiGate<1>, pg8::StaticOrder, true, true>(lds, g, S, E);
        if (tid == 0) __hip_atomic_fetch_add(gbar + 961, 1u, __ATOMIC_RELAXED, __HIP_MEMORY_SCOPE_AGENT);
        TILE_SYNC(S, 768);
    }
#define WAIT_COUNT(WORD) do { if (tid == 0) { while (__hip_atomic_load(gbar + (WORD), __ATOMIC_RELAXED, __HIP_MEMORY_SCOPE_AGENT) < (unsigned)G) __builtin_amdgcn_s_sleep(2); \
        __builtin_amdgcn_fence(__ATOMIC_ACQUIRE, "agent"); } __syncthreads(); } while (0)
    {
        WAIT_COUNT(960);
        {
            pg8::Gemm g{MRG, WO, T, DM, DM}; pg8::StaticOrder S; S.init(T, DM, G, vc);
            EpiResidN E{p.out, p.out, 1.0f, p.in[14], H, SSQ};
            pg8::gemm_phase<EpiResidN, pg8::StaticOrder, true, true>(lds, g, S, E);
        }
        WAIT_COUNT(961);
        constexpr int NIT = 3 * (DM / 64) * (DFF / 64);
        for (int it0 = gw; it0 < NIT; it0 += NGW) {
            int it = it0;
            if (transpose_seg(it, p.in[15], DM, DFF, WGU, 1, scr, lane)) continue;
            if (transpose_seg(it, p.in[16], DM, DFF, WGU, 2, scr, lane)) continue;
            transpose_seg(it, p.in[17], DFF, DM, WD, 0, scr, lane);
        }
    }
    GRID_SYNC();
    {
        pg8::Gemm g{H, WGU, T, 2 * DFF, DM}; pg8::StaticOrder S; S.init(T, 2 * DFF, G, vc);
        FILL_RTAB(S, true);
        EpiSwiGLU E{ACT, rtab};
        pg8::gemm_phase<EpiSwiGLU, pg8::StaticOrder, true, true>(lds, g, S, E);
        TILE_SYNC(S, 704);
    }
    {
        pg8::Gemm g{ACT, WD, T, DM, DFF}; pg8::StaticOrder S; S.init(T, DM, G, vc);
        EpiResid E{p.out, p.out, 0.5f};
        pg8::gemm_phase<EpiResid, pg8::StaticOrder, true, true>(lds, g, S, E);
        pg8::Unit u0;
        if (G == 256 && S.next(0, u0)) {
            unsigned* const pc = gbar + 576 + u0.pm;
            asm volatile("s_waitcnt vmcnt(0) lgkmcnt(0)" ::: "memory"); __syncthreads();
            if (tid == 0) {
                __builtin_amdgcn_fence(__ATOMIC_RELEASE, "agent"); asm volatile("s_waitcnt vmcnt(0)" ::: "memory");
                misc[2] = __hip_atomic_fetch_add(pc, 1u, __ATOMIC_RELAXED, __HIP_MEMORY_SCOPE_AGENT);
                while (__hip_atomic_load(pc, __ATOMIC_RELAXED, __HIP_MEMORY_SCOPE_AGENT) < 4u) __builtin_amdgcn_s_sleep(2);
                __builtin_amdgcn_fence(__ATOMIC_ACQUIRE, "agent"); asm volatile("s_waitcnt vmcnt(0)" ::: "memory");
            }
            __syncthreads();
            const int q = (int)(misc[2] & 3u);
            for (int r = wave; r < 64; r += NWAVES) { const size_t m = (size_t)u0.pm * 256 + 64 * q + r; rms_row_f32(p.out + m * DM, p.in[18], p.out + m * DM, lane); }
        } else {
            GRID_SYNC();
            for (int m = gw; m < T; m += NGW) rms_row_f32(p.out + (size_t)m * DM, p.in[18], p.out + (size_t)m * DM, lane);
        }
    }
}

extern "C" void kernel_launch(void* const* d_in, const int* in_sizes, int n_in, void* d_out, int out_size, void* d_ws, size_t ws_size, hipStream_t stream) {
    static int grid = 0;
    if (grid == 0) {
        if (n_in != 19 || out_size != T * DM || ws_size < WS_NEED) { fprintf(stderr, "kernel_launch: unexpected shapes (n_in %d out %d ws %zu need %zu)\n", n_in, out_size, ws_size, (size_t)WS_NEED); grid = -1; return; }
        int dev = 0, cus = 0, per_cu = 0;
        (void)hipGetDevice(&dev); (void)hipDeviceGetAttribute(&cus, hipDeviceAttributeMultiprocessorCount, dev);
        if (hipFuncSetAttribute((const void*)mega_fwd, hipFuncAttributeMaxDynamicSharedMemorySize, LDS_BYTES) != hipSuccess) { fprintf(stderr, "kernel_launch: hipFuncSetAttribute failed\n"); }
        if (hipOccupancyMaxActiveBlocksPerMultiprocessor(&per_cu, (const void*)mega_fwd, NWAVES * 64, LDS_BYTES) != hipSuccess || per_cu < 1) per_cu = 1;
        (void)hipGetLastError();
        grid = cus * 1;
        if (grid <= 0) grid = 256;
    }
    if (grid < 0) return;
    Params p{};
    for (int i = 0; i < 19; ++i) p.in[i] = (const float*)d_in[i];
    p.out = (float*)d_out; p.ws = (unsigned char*)d_ws;
    for (int i = 0; i < 16; ++i) p.inv_freq[i] = (float)pow(500000.0, -(double)(2 * i) / 32.0);
    void* args[] = {&p};
    hipError_t e = hipLaunchCooperativeKernel((const void*)mega_fwd, dim3(grid), dim3(NWAVES * 64), args, LDS_BYTES, stream);
    if (e != hipSuccess) fprintf(stderr, "cooperative launch failed: %s (grid %d)\n", hipGetErrorString(e), grid);
}
```
